# Optimizing an MI355X kernel written in HIP

```python
import jax, jax.numpy as jnp
from jax import lax
import numpy as np

D_MODEL = 1024
BATCH = 4
SEQ = 8192
DEPTH = 1
DEC_BATCH = 16
DEC_SEQ = 64
PAST_LEN = 1024

CHUNK = 64
POOL_WINDOWS = (2, 4, 8, 16)
N_POOL_GROUPS = len(POOL_WINDOWS)
POOL_WIDTH = D_MODEL // 2
POOL_GROUP_DIM = POOL_WIDTH // N_POOL_GROUPS
POOL_HIST = max(POOL_WINDOWS) - 1
GMLP_CHUNK = 128
N_GMLP_HEADS = 4
GMLP_WIDTH = D_MODEL - POOL_WIDTH
GMLP_HEAD_DIM = GMLP_WIDTH // N_GMLP_HEADS
MIX_WIDTH = POOL_WIDTH + GMLP_WIDTH
IN_WIDTH = POOL_WIDTH + 2 * GMLP_WIDTH
D_FF = 4 * D_MODEL
EPS = 1e-6

kernel_name = "hymba_pool_gmlp_stream_step"


def _rmsnorm(x, g):
    xf = x.astype(jnp.float32)
    y = xf * lax.rsqrt(jnp.mean(xf * xf, axis=-1, keepdims=True) + EPS)
    return (y * g.astype(jnp.float32)).astype(x.dtype)


def _pool_mixer(a, hist, pos0, pool_w, pool_scale):
    B, T, _ = a.shape
    xc = jnp.concatenate([hist.astype(a.dtype), a], axis=1)
    cs = jnp.cumsum(xc.astype(jnp.float32), axis=1)
    cs0 = jnp.concatenate([jnp.zeros((B, 1, POOL_WIDTH), jnp.float32), cs], axis=1)
    pos = pos0 + jnp.arange(T)
    means = []
    for g, w in enumerate(POOL_WINDOWS):
        sl = slice(g * POOL_GROUP_DIM, (g + 1) * POOL_GROUP_DIM)
        s = cs0[:, POOL_HIST + 1:, sl] - cs0[:, POOL_HIST + 1 - w:POOL_HIST + 1 - w + T, sl]
        cnt = jnp.minimum(pos + 1, w).astype(jnp.float32)
        means.append(s / cnt[None, :, None])
    m = jnp.concatenate(means, axis=-1)
    d = (m - a.astype(jnp.float32)).astype(a.dtype)
    d = d.reshape(B, T, N_POOL_GROUPS, POOL_GROUP_DIM)
    out = jnp.einsum('btgc,gce->btge', d, pool_w).reshape(B, T, POOL_WIDTH) * pool_scale
    new_hist = xc[:, -POOL_HIST:]
    return out, new_hist


def _gmlp_gate(u, v, gmlp_ws, gmlp_b):
    B, T, _ = v.shape
    L = min(T, GMLP_CHUNK)
    idx = jnp.arange(L)
    mask = (idx[None, :] // CHUNK) <= (idx[:, None] // CHUNK)
    wsm = jnp.where(mask[None], gmlp_ws[:, :L, :L], jnp.zeros((), gmlp_ws.dtype))
    vr = v.reshape(B, T // L, L, N_GMLP_HEADS, GMLP_HEAD_DIM)
    mixed = jnp.einsum('gij,bnjgd->bnigd', wsm, vr)
    mixed = mixed + gmlp_b[:, :L].T[None, None, :, :, None]
    return u * mixed.reshape(B, T, GMLP_WIDTH)


def _layer(x, pool_hist, pos0, norm1_g, w_in, pool_w, pool_scale, gmlp_ws, gmlp_b,
           w_out, norm2_g, w_up, w_down):
    h = _rmsnorm(x, norm1_g)
    z = h @ w_in
    a = z[..., :POOL_WIDTH]
    u = jax.nn.gelu(z[..., POOL_WIDTH:POOL_WIDTH + GMLP_WIDTH])
    v = jax.nn.gelu(z[..., POOL_WIDTH + GMLP_WIDTH:])
    pool_out, new_hist = _pool_mixer(a, pool_hist, pos0, pool_w, pool_scale)
    gmlp_out = _gmlp_gate(u, v, gmlp_ws, gmlp_b)
    x = x + jnp.concatenate([pool_out, gmlp_out], axis=-1) @ w_out
    f = _rmsnorm(x, norm2_g) @ w_up
    x = x + jnp.square(jax.nn.relu(f)) @ w_down
    return x, new_hist, v


def setup_inputs(seed: int = 0) -> dict:
    key = jax.random.key(seed)
    ks = jax.random.split(key, 16)
    f32 = jnp.float32
    nrm = lambda k, s, sc: jax.random.normal(k, s, f32) * sc
    return {
        "x_prompt": nrm(ks[0], (BATCH, SEQ, D_MODEL), 1.0),
        "x_sample": nrm(ks[1], (DEC_BATCH, DEC_SEQ, D_MODEL), 1.0),
        "state_pool": nrm(ks[2], (DEPTH, DEC_BATCH, POOL_HIST, POOL_WIDTH), 1.0),
        "norm1_g": 1.0 + nrm(ks[3], (DEPTH, D_MODEL), 0.02),
        "w_in": nrm(ks[4], (DEPTH, D_MODEL, IN_WIDTH), D_MODEL ** -0.5),
        "pool_w": nrm(ks[5], (DEPTH, N_POOL_GROUPS, POOL_GROUP_DIM, POOL_GROUP_DIM), POOL_GROUP_DIM ** -0.5),
        "pool_scale": 1.0 + nrm(ks[6], (DEPTH, POOL_WIDTH), 0.1),
        "gmlp_ws": nrm(ks[7], (DEPTH, N_GMLP_HEADS, GMLP_CHUNK, GMLP_CHUNK), GMLP_CHUNK ** -0.5),
        "gmlp_b": 1.0 + nrm(ks[8], (DEPTH, N_GMLP_HEADS, GMLP_CHUNK), 0.1),
        "w_out": nrm(ks[9], (DEPTH, MIX_WIDTH, D_MODEL), MIX_WIDTH ** -0.5),
        "norm2_g": 1.0 + nrm(ks[10], (DEPTH, D_MODEL), 0.02),
        "w_up": nrm(ks[11], (DEPTH, D_MODEL, D_FF), D_MODEL ** -0.5),
        "w_down": nrm(ks[12], (DEPTH, D_FF, D_MODEL), D_FF ** -0.5),
        "normf_g": 1.0 + nrm(ks[13], (D_MODEL,), 0.02),
    }


def reference(x_prompt, x_sample, state_pool, norm1_g, w_in, pool_w, pool_scale, gmlp_ws,
              gmlp_b, w_out, norm2_g, w_up, w_down, normf_g):
    hp = x_prompt
    hs = x_sample
    pool_p, pool_s, v_s = [], [], []
    for l in range(DEPTH):
        zero_hist = jnp.zeros((hp.shape[0], POOL_HIST, POOL_WIDTH), hp.dtype)
        hp, nhp, _ = _layer(hp, zero_hist, 0, norm1_g[l], w_in[l], pool_w[l], pool_scale[l],
                            gmlp_ws[l], gmlp_b[l], w_out[l], norm2_g[l], w_up[l], w_down[l])
        hs, nhs, vs = _layer(hs, state_pool[l], PAST_LEN, norm1_g[l], w_in[l], pool_w[l],
                             pool_scale[l], gmlp_ws[l], gmlp_b[l], w_out[l], norm2_g[l],
                             w_up[l], w_down[l])
        pool_p.append(nhp)
        pool_s.append(nhs)
        v_s.append(vs)
    y_prompt = _rmsnorm(hp, normf_g)
    y_sample = _rmsnorm(hs, normf_g)
    state_pool_prompt = jnp.stack(pool_p, axis=0)
    state_pool_sample = jnp.stack(pool_s, axis=0)
    state_gmlp_v_sample = jnp.stack(v_s, axis=0)
    return (y_prompt, y_sample, state_pool_prompt, state_pool_sample, state_gmlp_v_sample)
```

```cpp
#include <hip/hip_runtime.h>
#include <cstdio>
#include <cstdint>
namespace pg8 {
#define PG8_LAS __attribute__((address_space(3)))
typedef unsigned short bf16_t;
typedef short bf16x8 __attribute__((ext_vector_type(8)));
typedef float f32x4 __attribute__((ext_vector_type(4)));
typedef unsigned u32x4 __attribute__((ext_vector_type(4)));
constexpr int BM = 256, BK = 64, HALF = 128, HTB = HALF * BK * 2  , STAGE_BYTES = 8 * HTB, NXCD = 8, WGM = 8;

__host__ __device__ __forceinline__ int lds_byte(int r, int c) { const int st = (r >> 4) * 2 + (c >> 5), rr = r & 15, cc = c & 31, ob = rr * 64 + cc * 2; return st * 1024 + (ob ^ (((ob >> 9) & 1) << 5)); }
__host__ __device__ __forceinline__ void stage_rc(int b, int& R, int& C) { const int st = b / 1024, sb = b % 1024, swz = sb ^ (((sb >> 9) & 1) << 5); R = (st >> 1) * 16 + swz / 64; C = (st & 1) * 32 + (swz % 64) / 2; }
__host__ __device__ __forceinline__ int perm32(int rho) { const int n = rho >> 4, i = rho & 15; return 8 * (i >> 2) + 4 * n + (i & 3); }

struct Unit { int pm, pn, k0, nt; };
struct Gemm { const bf16_t* A; const bf16_t* Bt; int M, N, K; };

struct StaticOrder {
    int nM, nN, nwg, G, c, nt0, pm_base;
    __host__ __device__ void init(int M, int N, int K, int G_, int c_) { nM = M / BM; nN = N / BM; nwg = nM * nN; G = G_; c = c_; nt0 = K / BK; pm_base = 0; }
    __host__ __device__ bool next(int i, Unit& u) const {
        const long L = (long)i * G + c; if (L >= nwg) return false;
        int wgid = (int)L; { const int q = nwg / NXCD, r = nwg % NXCD, xcd = wgid % NXCD, off = wgid / NXCD; wgid = (xcd < r ? xcd * (q + 1) : r * (q + 1) + (xcd - r) * q) + off; }
        const int nig = WGM * nN, gid = wgid / nig, fm = gid * WGM, gsz = (nM - fm) < WGM ? (nM - fm) : WGM;
        u.pm = pm_base + fm + ((wgid % nig) % gsz); u.pn = (wgid % nig) / gsz; u.k0 = 0; u.nt = nt0; return true;
    }
    __device__ __forceinline__ void a_ready(const Unit&) const {}
    __device__ __forceinline__ void done(const Unit&) const {}
};

__device__ __forceinline__ unsigned cvt_pk_bf16(float lo, float hi) { unsigned r; asm volatile("v_cvt_pk_bf16_f32 %0, %1, %2" : "=v"(r) : "v"(lo), "v"(hi)); return r; }
typedef float f32x2 __attribute__((ext_vector_type(2)));
__device__ __forceinline__ f32x2 gelu_pk(f32x2 v) {
    const f32x2 av = __builtin_elementwise_abs(v), d = av * 0.2316418882f + 1.0f;
    f32x2 t; t.x = __builtin_amdgcn_rcpf(d.x); t.y = __builtin_amdgcn_rcpf(d.y);
    f32x2 q = t * 0.5307027145f + (-0.7265760135f); q = q * t + 0.7107068705f; q = q * t + (-0.142248368f); q = q * t + 0.127414796f; q = q * t;
    const f32x2 s = (v * v) * (-0.72134752044f);
    f32x2 e; e.x = __builtin_amdgcn_exp2f(s.x); e.y = __builtin_amdgcn_exp2f(s.y);
    const f32x2 m = v * (q * e), r = v - m;
    f32x2 o; o.x = v.x < 0.f ? m.x : r.x; o.y = v.y < 0.f ? m.y : r.y; return o;
}

template <class Epi, class Sched, bool ALIGN_EPI = false, bool SP2 = false>
__device__ __forceinline__ void gemm_phase(PG8_LAS unsigned char* lds, const Gemm g, const Sched& S, const Epi& E) {
    const int tid = threadIdx.x, wid = __builtin_amdgcn_readfirstlane(tid >> 6), lane = tid & 63, wr = wid >> 2, wc = wid & 3, fr = lane & 15, fq = lane >> 4;
    const int K = g.K;
    unsigned voffA[2], voffB[2];
#pragma unroll
    for (int i = 0; i < 2; ++i) { int R, C; stage_rc(tid * 16 + i * 8192, R, C); const int Rb = Epi::PERM ? ((R & ~31) + perm32(R & 31)) : R;
        voffA[i] = (unsigned)(R * K + C) * 2u; voffB[i] = (unsigned)(Rb * K + C) * 2u; }
    const size_t kstep = (size_t)(BK * 2);
    const size_t hstep = (size_t)HALF * K * 2;
    const size_t tstep = 2 * hstep;
    const unsigned ldsw = (unsigned)wid * 1024u;
    const int aoff = lds_byte(wr * 64 + fr, fq * 8), boff = lds_byte(wc * 32 + fr, fq * 8);
#define PG8_SA(b, h) (((b) * 2 + (h)) * HTB)
#define PG8_SB(b, h) ((4 + (b) * 2 + (h)) * HTB)
#define PG8_STAGE(bufoff, gbase, voff) do { _Pragma("unroll") for (int _i = 0; _i < 2; ++_i) \
        __builtin_amdgcn_global_load_lds((const unsigned*)((const char*)(gbase) + (voff)[_i]), (PG8_LAS unsigned*)(lds + (bufoff) + ldsw + _i * 8192), 16, 0, 0); } while (0)
#define PG8_LDA(dst, b, h) do { _Pragma("unroll") for (int m = 0; m < 4; ++m) _Pragma("unroll") for (int k = 0; k < 2; ++k) dst[m][k] = *(const PG8_LAS bf16x8*)(lds + PG8_SA(b, h) + aoff + m * 2048 + k * 1024); } while (0)
#define PG8_LDB(dst, b, h) do { _Pragma("unroll") for (int n = 0; n < 2; ++n) _Pragma("unroll") for (int k = 0; k < 2; ++k) dst[n][k] = *(const PG8_LAS bf16x8*)(lds + PG8_SB(b, h) + boff + n * 2048 + k * 1024); } while (0)
#define PG8_MMA(ai, bj, At, Bt) do { __builtin_amdgcn_s_setprio(1); _Pragma("unroll") for (int m = 0; m < 4; ++m) _Pragma("unroll") for (int n = 0; n < 2; ++n) _Pragma("unroll") for (int k = 0; k < 2; ++k) \
        acc[ai][bj][m][n] = __builtin_amdgcn_mfma_f32_16x16x32_bf16(Bt[n][k], At[m][k], acc[ai][bj][m][n], 0, 0, 0); __builtin_amdgcn_s_setprio(0); } while (0)
#define PG8_WAIT_V(n) asm volatile("s_waitcnt vmcnt(" #n ")" ::: "memory")
#define PG8_WAIT_L(n) asm volatile("s_waitcnt lgkmcnt(" #n ")" ::: "memory")
#define PG8_BAR __builtin_amdgcn_s_barrier()
#define PG8_SCHED __builtin_amdgcn_sched_barrier(0)
    Unit cur, nxt; int ui = 0;
    if (!S.next(0, cur)) return;
    f32x4 acc[2][2][4][2];
#pragma unroll
    for (int a = 0; a < 2; ++a)
#pragma unroll
        for (int b = 0; b < 2; ++b)
#pragma unroll
            for (int m = 0; m < 4; ++m)
#pragma unroll
                for (int n = 0; n < 2; ++n) acc[a][b][m][n] = (f32x4){0.f, 0.f, 0.f, 0.f};
    bf16x8 At[4][2], B0[2][2], B1[2][2];
    const char* cA = (const char*)g.A + (size_t)cur.pm * tstep + (size_t)cur.k0 * 2; const char* cB = (const char*)g.Bt + (size_t)cur.pn * tstep + (size_t)cur.k0 * 2;
    S.a_ready(cur);
    if constexpr (SP2) {
        PG8_STAGE(PG8_SB(0, 0), cB, voffB); PG8_STAGE(PG8_SB(0, 1), cB + hstep, voffB); PG8_STAGE(PG8_SA(0, 0), cA, voffA); PG8_STAGE(PG8_SA(0, 1), cA + hstep, voffA);
        if (wr == 1) PG8_BAR;
        PG8_WAIT_V(2); PG8_BAR;
        PG8_STAGE(PG8_SB(1, 0), cB + kstep, voffB); PG8_STAGE(PG8_SA(1, 0), cA + kstep, voffA); PG8_STAGE(PG8_SB(1, 1), cB + hstep + kstep, voffB);
        PG8_WAIT_V(6); PG8_BAR;
    } else {
        PG8_STAGE(PG8_SB(0, 0), cB, voffB); PG8_STAGE(PG8_SA(0, 0), cA, voffA); PG8_STAGE(PG8_SB(0, 1), cB + hstep, voffB); PG8_STAGE(PG8_SA(0, 1), cA + hstep, voffA);
        if (wr == 1) PG8_BAR;
        PG8_WAIT_V(4); PG8_BAR;
        PG8_STAGE(PG8_SB(1, 0), cB + kstep, voffB); PG8_STAGE(PG8_SA(1, 0), cA + kstep, voffA); PG8_STAGE(PG8_SB(1, 1), cB + hstep + kstep, voffB);
        PG8_WAIT_V(6); PG8_BAR;
    }
    for (;;) {
        const bool has_next = S.next(ui + 1, nxt);
        const char* nA = has_next ? (const char*)g.A + (size_t)nxt.pm * tstep + (size_t)nxt.k0 * 2 : cA; const char* nB = has_next ? (const char*)g.Bt + (size_t)nxt.pn * tstep + (size_t)nxt.k0 * 2 : cB;
        const int nt = cur.nt;
        for (int t = 0; t < nt; t += 2) {
            const bool last = (t == nt - 2);
            const char* a1 = cA + (size_t)(t + 1) * kstep;
            const char* a2 = last ? nA : cA + (size_t)(t + 2) * kstep; const char* b2 = last ? nB : cB + (size_t)(t + 2) * kstep;
            const char* a3 = a2 + kstep; const char* b3 = b2 + kstep;
            if (last && has_next) S.a_ready(nxt);
            if constexpr (SP2) {
            PG8_LDB(B0, 0, 0); PG8_LDB(B1, 0, 1); PG8_SCHED; PG8_LDA(At, 0, 0); PG8_STAGE(PG8_SA(1, 1), a1 + hstep, voffA);
            PG8_WAIT_V(8); PG8_WAIT_L(0); PG8_BAR; PG8_MMA(0, 0, At, B0); PG8_MMA(0, 1, At, B1); PG8_BAR; PG8_SCHED;
            PG8_LDA(At, 0, 1); PG8_STAGE(PG8_SB(0, 0), b2, voffB); PG8_STAGE(PG8_SB(0, 1), b2 + hstep, voffB); PG8_STAGE(PG8_SA(0, 0), a2, voffA);
            PG8_WAIT_V(8); PG8_WAIT_L(0); PG8_BAR; PG8_MMA(1, 0, At, B0); PG8_MMA(1, 1, At, B1); PG8_BAR; PG8_SCHED;
            PG8_LDB(B0, 1, 0); PG8_LDB(B1, 1, 1); PG8_SCHED; PG8_LDA(At, 1, 0); PG8_STAGE(PG8_SA(0, 1), a2 + hstep, voffA);
            PG8_WAIT_V(8); PG8_WAIT_L(0); PG8_BAR; PG8_MMA(0, 0, At, B0); PG8_MMA(0, 1, At, B1); PG8_BAR; PG8_SCHED;
            PG8_LDA(At, 1, 1); PG8_STAGE(PG8_SB(1, 0), b3, voffB); PG8_STAGE(PG8_SB(1, 1), b3 + hstep, voffB); PG8_STAGE(PG8_SA(1, 0), a3, voffA);
            PG8_WAIT_V(8); PG8_WAIT_L(0); PG8_BAR; PG8_MMA(1, 0, At, B0); PG8_MMA(1, 1, At, B1); PG8_BAR; PG8_SCHED;
            } else {
            PG8_LDB(B0, 0, 0); PG8_SCHED; PG8_LDA(At, 0, 0); PG8_STAGE(PG8_SA(1, 1), a1 + hstep, voffA);
            PG8_WAIT_L(8); PG8_BAR; PG8_WAIT_L(0); PG8_MMA(0, 0, At, B0); PG8_BAR; PG8_SCHED;
            PG8_LDB(B1, 0, 1); PG8_STAGE(PG8_SB(0, 0), b2, voffB);
            PG8_BAR; PG8_WAIT_L(0); PG8_MMA(0, 1, At, B1); PG8_BAR;
            PG8_LDA(At, 0, 1); PG8_STAGE(PG8_SA(0, 0), a2, voffA);
            PG8_BAR; PG8_WAIT_L(0); PG8_MMA(1, 0, At, B0); PG8_BAR; PG8_SCHED;
            PG8_STAGE(PG8_SB(0, 1), b2 + hstep, voffB);
            PG8_WAIT_V(6); PG8_BAR; PG8_MMA(1, 1, At, B1); PG8_BAR;
            PG8_LDB(B0, 1, 0); PG8_SCHED; PG8_LDA(At, 1, 0); PG8_STAGE(PG8_SA(0, 1), a2 + hstep, voffA);
            PG8_WAIT_L(8); PG8_BAR; PG8_WAIT_L(0); PG8_MMA(0, 0, At, B0); PG8_BAR; PG8_SCHED;
            PG8_LDB(B1, 1, 1); PG8_STAGE(PG8_SB(1, 0), b3, voffB);
            PG8_BAR; PG8_WAIT_L(0); PG8_MMA(0, 1, At, B1); PG8_BAR;
            PG8_LDA(At, 1, 1); PG8_STAGE(PG8_SA(1, 0), a3, voffA);
            PG8_BAR; PG8_WAIT_L(0); PG8_MMA(1, 0, At, B0); PG8_BAR; PG8_SCHED;
            PG8_STAGE(PG8_SB(1, 1), b3 + hstep, voffB);
            PG8_WAIT_V(6); PG8_BAR; PG8_MMA(1, 1, At, B1); PG8_BAR;
            }
        }
        if constexpr (ALIGN_EPI) { if (wr == 0) PG8_BAR; }
        if constexpr (!Epi::AFTER_DRAIN) { E(acc, cur, wr, wc, fr, fq); S.done(cur); }
        if (!has_next) break;
#pragma unroll
        for (int a = 0; a < 2; ++a)
#pragma unroll
            for (int b = 0; b < 2; ++b)
#pragma unroll
                for (int m = 0; m < 4; ++m)
#pragma unroll
                    for (int n = 0; n < 2; ++n) acc[a][b][m][n] = (f32x4){0.f, 0.f, 0.f, 0.f};
        cur = nxt; cA = nA; cB = nB; ++ui;
        if constexpr (ALIGN_EPI) { if (wr == 1) PG8_BAR; }
    }
    PG8_WAIT_V(0);
    if constexpr (!ALIGN_EPI) { if (wr == 0) PG8_BAR; }
    PG8_BAR;
    if constexpr (Epi::AFTER_DRAIN) { E.fused(acc, cur, wr, wc, fr, fq, lds, wid, lane); S.done(cur); }
#undef PG8_SA
#undef PG8_SB
#undef PG8_STAGE
#undef PG8_LDA
#undef PG8_LDB
#undef PG8_MMA
#undef PG8_WAIT_V
#undef PG8_WAIT_L
#undef PG8_BAR
#undef PG8_SCHED
}
}
#define LAS __attribute__((address_space(3)))
#ifndef PROBE
#define PROBE 0
#endif
typedef unsigned short bf16;
typedef pg8::f32x4 f32x4;
typedef pg8::u32x4 u32x4;
typedef pg8::bf16x8 bf16x8;
typedef unsigned u32x2 __attribute__((ext_vector_type(2)));
constexpr int D = 1024, SEQ = 8192, NP = 4 * SEQ, DSEQ = 64, NS = 16 * DSEQ, M = NP + NS;
constexpr int INW = 1536, PW = 512, FF = 4096, HIST = 15;
constexpr float EPS = 1e-6f;
constexpr size_t O_SPP = (size_t)M * D, O_SPS = O_SPP + 4 * HIST * PW, O_VS = O_SPS + 16 * HIST * PW, O_END = O_VS + (size_t)NS * 512;
constexpr size_t MiB = 1u << 20;
constexpr size_t WS_H = 0;
constexpr size_t WS_XB = 0;
constexpr size_t WS_Z = 66 * MiB;
constexpr size_t WS_MIX = 165 * MiB;
constexpr size_t WS_XB1 = 264 * MiB;
constexpr size_t WS_WIN = 330 * MiB, WS_WO = 333 * MiB, WS_WUP = 335 * MiB, WS_WDN = 343 * MiB, WS_WM = 351 * MiB;
constexpr size_t WS_RS0 = 352 * MiB, WS_SSQ1 = 353 * MiB, WS_HB = 354 * MiB, WS_CTL = 355 * MiB, WS_PART = 356 * MiB, WS_X2B = 420 * MiB, WS_END = 486 * MiB;
constexpr size_t CTL_ZERO_BYTES = 16384;
constexpr int BARST_OFF = 131072 + 64;
constexpr int LDS_BYTES = 147456;

__device__ __forceinline__ unsigned f2bf(float f) { unsigned u = __builtin_bit_cast(unsigned, f); return (u + 0x7fffu + ((u >> 16) & 1u)) >> 16; }
__device__ __forceinline__ unsigned pk2(float lo, float hi) { return f2bf(lo) | (f2bf(hi) << 16); }
__device__ __forceinline__ float bflo(unsigned w) { return __builtin_bit_cast(float, w << 16); }
__device__ __forceinline__ float bfhi(unsigned w) { return __builtin_bit_cast(float, w & 0xffff0000u); }
__device__ __forceinline__ float wave_sum(float v) {
#pragma unroll
    for (int o = 1; o < 64; o <<= 1) v += __shfl_xor(v, o);
    return v;
}
__device__ __forceinline__ float gelu_tanh(float x) {
    const float y = x * (1.0f + 0.044715f * x * x);
    const float e = __builtin_amdgcn_exp2f(-2.302208198f * y);
    return x * __builtin_amdgcn_rcpf(1.0f + e);
}

struct EpiIn {
    static constexpr bool PERM = true, AFTER_DRAIN = false;
    bf16* Z; const float* rs0; float* out;
    __device__ __forceinline__ void operator()(const f32x4 (&acc)[2][2][4][2], const pg8::Unit& u, int wr, int wc, int fr, int fq) const {
        const int row0 = u.pm * 256 + wr * 64 + fr, col0 = u.pn * 256 + wc * 32 + 8 * fq, kind = u.pn >> 1;
        float sc[2][4];
#pragma unroll
        for (int ai = 0; ai < 2; ++ai)
#pragma unroll
            for (int m = 0; m < 4; ++m) sc[ai][m] = rs0[row0 + ai * 128 + m * 16];
#pragma unroll
        for (int ai = 0; ai < 2; ++ai)
#pragma unroll
            for (int m = 0; m < 4; ++m) {
                const int row = row0 + ai * 128 + m * 16; const float s = sc[ai][m];
                bf16* zr = Z + (size_t)row * INW + col0;
                float* side = nullptr;
                if (kind == 0) {
                    if (row < NP) { const int t = row & (SEQ - 1); if (t >= SEQ - HIST) side = out + O_SPP + (size_t)((row >> 13) * HIST + t - (SEQ - HIST)) * PW + col0; }
                    else { const int r2 = row - NP, t = r2 & (DSEQ - 1); if (t >= DSEQ - HIST) side = out + O_SPS + (size_t)((r2 >> 6) * HIST + t - (DSEQ - HIST)) * PW + col0; }
                } else if (kind == 2 && row >= NP) side = out + O_VS + (size_t)(row - NP) * 512 + (col0 - 1024);
#pragma unroll
                for (int bj = 0; bj < 2; ++bj) {
                    f32x4 v0 = acc[ai][bj][m][0] * s, v1 = acc[ai][bj][m][1] * s;
                    if (kind) {
#pragma unroll
                        for (int e = 0; e < 4; ++e) { v0[e] = gelu_tanh(v0[e]); v1[e] = gelu_tanh(v1[e]); }
                    }
                    u32x4 w; w.x = pg8::cvt_pk_bf16(v0[0], v0[1]); w.y = pg8::cvt_pk_bf16(v0[2], v0[3]); w.z = pg8::cvt_pk_bf16(v1[0], v1[1]); w.w = pg8::cvt_pk_bf16(v1[2], v1[3]);
                    *(u32x4*)(zr + bj * 128) = w;
                    if (side) { *(f32x4*)(side + bj * 128) = v0; *(f32x4*)(side + bj * 128 + 4) = v1; }
                }
            }
    }
};
struct EpiNone {
    static constexpr bool PERM = true, AFTER_DRAIN = false;
    float* sink;
    __device__ __forceinline__ void operator()(const f32x4 (&acc)[2][2][4][2], const pg8::Unit& u, int wr, int wc, int fr, int fq) const {
        f32x4 t = (f32x4){0.f, 0.f, 0.f, 0.f};
#pragma unroll
        for (int ai = 0; ai < 2; ++ai)
#pragma unroll
            for (int bj = 0; bj < 2; ++bj)
#pragma unroll
                for (int m = 0; m < 4; ++m) t += acc[ai][bj][m][0] + acc[ai][bj][m][1];
        if (t[0] + t[1] + t[2] + t[3] == 123.456f) sink[0] = t[0];
    }
};
struct EpiOut {
    static constexpr bool PERM = true, AFTER_DRAIN = false;
    const bf16* XB; bf16* XB1; float* ssq;
    __device__ __forceinline__ void operator()(const f32x4 (&acc)[2][2][4][2], const pg8::Unit& u, int wr, int wc, int fr, int fq) const {
        const int row0 = u.pm * 256 + wr * 64 + fr, col0 = u.pn * 256 + wc * 32 + 8 * fq;
#pragma unroll
        for (int ai = 0; ai < 2; ++ai) {
            u32x4 pre[4][2];
#pragma unroll
            for (int m = 0; m < 4; ++m)
#pragma unroll
                for (int bj = 0; bj < 2; ++bj) pre[m][bj] = *(const u32x4*)(XB + (size_t)(row0 + ai * 128 + m * 16) * D + col0 + bj * 128);
#pragma unroll
            for (int m = 0; m < 4; ++m) {
                const int row = row0 + ai * 128 + m * 16;
                bf16* brow = XB1 + (size_t)row * D + col0; float q = 0.f;
#pragma unroll
                for (int bj = 0; bj < 2; ++bj) {
                    const u32x4 r = pre[m][bj];
                    const f32x4 o0 = acc[ai][bj][m][0] + (f32x4){bflo(r.x), bfhi(r.x), bflo(r.y), bfhi(r.y)}, o1 = acc[ai][bj][m][1] + (f32x4){bflo(r.z), bfhi(r.z), bflo(r.w), bfhi(r.w)};
                    u32x4 w; w.x = pg8::cvt_pk_bf16(o0[0], o0[1]); w.y = pg8::cvt_pk_bf16(o0[2], o0[3]); w.z = pg8::cvt_pk_bf16(o1[0], o1[1]); w.w = pg8::cvt_pk_bf16(o1[2], o1[3]);
                    *(u32x4*)(brow + bj * 128) = w;
                    q += (o0[0] * o0[0] + o0[1] * o0[1]) + (o0[2] * o0[2] + o0[3] * o0[3]) + (o1[0] * o1[0] + o1[1] * o1[1]) + (o1[2] * o1[2] + o1[3] * o1[3]);
                }
                q += __shfl_xor(q, 16); q += __shfl_xor(q, 32);
                if (fq == 0) atomicAdd(ssq + row, q);
            }
            asm volatile("" ::: "memory");
        }
    }
};
struct EpiUp {
    static constexpr bool PERM = true, AFTER_DRAIN = false;
    bf16* H; const float* ssq;
    __device__ __forceinline__ void operator()(const f32x4 (&acc)[2][2][4][2], const pg8::Unit& u, int wr, int wc, int fr, int fq) const {
        const int row0 = u.pm * 256 + wr * 64 + fr, col0 = u.pn * 256 + wc * 32 + 8 * fq;
        float sc[2][4];
#pragma unroll
        for (int ai = 0; ai < 2; ++ai)
#pragma unroll
            for (int m = 0; m < 4; ++m) sc[ai][m] = ssq[row0 + ai * 128 + m * 16];
#pragma unroll
        for (int ai = 0; ai < 2; ++ai)
#pragma unroll
            for (int m = 0; m < 4; ++m) {
                const int row = row0 + ai * 128 + m * 16; const float s = __builtin_amdgcn_rsqf(sc[ai][m] * (1.0f / D) + EPS);
                bf16* hr = H + (size_t)row * FF + col0;
#pragma unroll
                for (int bj = 0; bj < 2; ++bj) {
                    f32x4 v0 = acc[ai][bj][m][0] * s, v1 = acc[ai][bj][m][1] * s;
#pragma unroll
                    for (int e = 0; e < 4; ++e) { const float a0 = fmaxf(v0[e], 0.f), a1 = fmaxf(v1[e], 0.f); v0[e] = a0 * a0; v1[e] = a1 * a1; }
                    u32x4 w; w.x = pg8::cvt_pk_bf16(v0[0], v0[1]); w.y = pg8::cvt_pk_bf16(v0[2], v0[3]); w.z = pg8::cvt_pk_bf16(v1[0], v1[1]); w.w = pg8::cvt_pk_bf16(v1[2], v1[3]);
                    __builtin_nontemporal_store(w, (u32x4*)(hr + bj * 128));
                }
            }
    }
};
struct SampleDownOrder {
    int G, c;
    __device__ void init(int G_, int c_) { G = G_; c = c_; }
    __device__ bool next(int i, pg8::Unit& u) const {
        const int L = i * G + c; if (L >= 256) return false;
        const int su = L >> 4, ks = L & 15; u.pm = NP / 256 + (su >> 2); u.pn = su & 3; u.k0 = ks * 256; u.nt = 4; return true;
    }
    __device__ __forceinline__ void a_ready(const pg8::Unit&) const {}
    __device__ __forceinline__ void done(const pg8::Unit&) const {}
};
struct EpiDown {
    static constexpr bool PERM = true, AFTER_DRAIN = false;
    const bf16* xsrc; bf16* x2; float* part;
    __device__ __forceinline__ void operator()(const f32x4 (&acc)[2][2][4][2], const pg8::Unit& u, int wr, int wc, int fr, int fq) const {
        const int row0 = u.pm * 256 + wr * 64 + fr, col0 = u.pn * 256 + wc * 32 + 8 * fq;
        if (u.nt != FF / 64) {
#pragma unroll
            for (int ai = 0; ai < 2; ++ai)
#pragma unroll
                for (int m = 0; m < 4; ++m) {
                    float* pr = part + ((size_t)(u.k0 >> 8) * NS + (size_t)(row0 + ai * 128 + m * 16 - NP)) * D + col0;
#pragma unroll
                    for (int bj = 0; bj < 2; ++bj) { *(f32x4*)(pr + bj * 128) = acc[ai][bj][m][0]; *(f32x4*)(pr + bj * 128 + 4) = acc[ai][bj][m][1]; }
                }
            return;
        }
#pragma unroll
        for (int ai = 0; ai < 2; ++ai) {
            u32x4 pre[4][2];
#pragma unroll
            for (int m = 0; m < 4; ++m)
#pragma unroll
                for (int bj = 0; bj < 2; ++bj) pre[m][bj] = *(const u32x4*)(xsrc + (size_t)(row0 + ai * 128 + m * 16) * D + col0 + bj * 128);
#pragma unroll
            for (int m = 0; m < 4; ++m) {
                bf16* xr = x2 + (size_t)(row0 + ai * 128 + m * 16) * D + col0;
#pragma unroll
                for (int bj = 0; bj < 2; ++bj) { const u32x4 r = pre[m][bj];
                    const f32x4 o0 = acc[ai][bj][m][0] + (f32x4){bflo(r.x), bfhi(r.x), bflo(r.y), bfhi(r.y)}, o1 = acc[ai][bj][m][1] + (f32x4){bflo(r.z), bfhi(r.z), bflo(r.w), bfhi(r.w)};
                    u32x4 w; w.x = pg8::cvt_pk_bf16(o0[0], o0[1]); w.y = pg8::cvt_pk_bf16(o0[2], o0[3]); w.z = pg8::cvt_pk_bf16(o1[0], o1[1]); w.w = pg8::cvt_pk_bf16(o1[2], o1[3]);
                    *(u32x4*)(xr + bj * 128) = w; }
            }
            asm volatile("" ::: "memory");
        }
    }
};

#define LDS_WAIT() asm volatile("s_waitcnt lgkmcnt(0)" ::: "memory")
__device__ __forceinline__ void p0_transpose_item(const float* W, int N, const float* gk, bf16* WT, int ldk, int koff, LAS unsigned char* scr, int item, int lane) {
    const int nblk = N / 128, kb = item / nblk, nb = item % nblk, k0 = 32 * kb, n0 = 128 * nb;
    f32x4 t[16];
#pragma unroll
    for (int i = 0; i < 16; ++i) t[i] = *(const f32x4*)(W + (size_t)(k0 + 2 * i + (lane >> 5)) * N + n0 + 4 * (lane & 31));
    if (gk) {
#pragma unroll
        for (int i = 0; i < 16; ++i) t[i] = t[i] * gk[k0 + 2 * i + (lane >> 5)];
    }
#pragma unroll
    for (int i = 0; i < 16; ++i) { u32x2 w; w.x = pk2(t[i].x, t[i].y); w.y = pk2(t[i].z, t[i].w); *(LAS u32x2*)(scr + (2 * i + (lane >> 5)) * 280 + 8 * (lane & 31)) = w; }
    LDS_WAIT(); asm volatile("" ::: "memory");
    const int kc = lane & 3;
#pragma unroll
    for (int j = 0; j < 8; ++j) { const int n = (lane >> 2) + 16 * j; const LAS unsigned short* sp = (const LAS unsigned short*)(scr + (8 * kc) * 280 + 2 * n);
        u32x4 o; o.x = (unsigned)sp[0] | ((unsigned)sp[140] << 16); o.y = (unsigned)sp[280] | ((unsigned)sp[420] << 16); o.z = (unsigned)sp[560] | ((unsigned)sp[700] << 16); o.w = (unsigned)sp[840] | ((unsigned)sp[980] << 16);
        *(u32x4*)(WT + (size_t)(n0 + n) * ldk + koff + k0 + 8 * kc) = o; }
    LDS_WAIT(); asm volatile("" ::: "memory");
}

#define XB_TMO      128
#define XB_XCNT(j)  (256  + 64 * (j))
#define XB_XSUB(j)  (1280 + 64 * (j))
#define XB_XGEN(j)  (2304 + 64 * (j))
#define XB_TOP      3328
#define XB_TOPGEN   3392
#define XCD_BAR_WORDS 3456
#define XB_SPIN_CAP (1u << 18)

__device__ __forceinline__ unsigned xb_ld(unsigned* p)              { return __hip_atomic_load(p, __ATOMIC_RELAXED, __HIP_MEMORY_SCOPE_AGENT); }
__device__ __forceinline__ unsigned xb_add(unsigned* p, unsigned v) { return __hip_atomic_fetch_add(p, v, __ATOMIC_RELAXED, __HIP_MEMORY_SCOPE_AGENT); }
__device__ __forceinline__ unsigned xb_xcc_id() { return (unsigned)__builtin_amdgcn_s_getreg((3 << 11) | 20) & 0xFu; }
#define XB_SPIN(cond, bar) do { unsigned _sp = 0; while (cond) { __builtin_amdgcn_s_sleep(1); \
    if ((++_sp & 255u) == 0u) { if (xb_ld(&(bar)[XB_TMO])) break; if (_sp > XB_SPIN_CAP) { atomicAdd(&(bar)[XB_TMO], 1u); break; } } } } while (0)

struct XcdBarrier {
    unsigned* bar; unsigned x;
    volatile LAS unsigned* st;
};

__device__ __forceinline__ XcdBarrier xcd_barrier_post(unsigned* bar, volatile LAS unsigned* st) {
    XcdBarrier b; b.bar = bar; b.x = xb_xcc_id(); b.st = st;
    if (threadIdx.x == 0) (void)xb_add(&bar[XB_XCNT(b.x)], 1u);
    return b;
}
__device__ __forceinline__ void xcd_barrier_complete(unsigned* bar, unsigned x, unsigned& nloc, unsigned& nx) {
    const unsigned G = gridDim.x * gridDim.y * gridDim.z;
    unsigned sum, cnt, mine, sp = 0u;
    for (;;) {
        sum = 0u; cnt = 0u; mine = 0u;
#pragma unroll
        for (unsigned j = 0; j < 16; ++j) { const unsigned c = xb_ld(&bar[XB_XCNT(j)]); sum += c; cnt += (c > 0u) ? 1u : 0u; mine = (j == x) ? c : mine; }
        if (sum == G) break;
        __builtin_amdgcn_s_sleep(1);
        if ((++sp & 255u) == 0u) { if (xb_ld(&bar[XB_TMO])) break; if (sp > XB_SPIN_CAP) { atomicAdd(&bar[XB_TMO], 1u); break; } }
    }
    nloc = mine > 0u ? mine : 1u; nx = cnt > 0u ? cnt : 1u;
}

__device__ __forceinline__ void xcd_barrier(const XcdBarrier& b) {
    asm volatile("s_waitcnt vmcnt(0)" ::: "memory");
    __syncthreads();
    if (threadIdx.x == 0) {
        unsigned* bar = b.bar;
        __builtin_amdgcn_s_waitcnt(0);
        unsigned nloc = b.st[0], nx = b.st[1];
        if (nloc == 0u) { xcd_barrier_complete(bar, b.x, nloc, nx); b.st[0] = nloc; b.st[1] = nx; }
        const unsigned old = xb_add(&bar[XB_XSUB(b.x)], 1u);
        const unsigned gen = old / nloc;
        if (old + 1u == (gen + 1u) * nloc) {
            __builtin_amdgcn_fence(__ATOMIC_RELEASE, "agent");
            asm volatile("s_waitcnt vmcnt(0)" ::: "memory");
            const unsigned og = xb_add(&bar[XB_TOP], 1u);
            const unsigned tg = og / nx;
            if (og + 1u == (tg + 1u) * nx) xb_add(&bar[XB_TOPGEN], 1u);
            else XB_SPIN(xb_ld(&bar[XB_TOPGEN]) == tg, bar);
            __builtin_amdgcn_fence(__ATOMIC_ACQUIRE, "agent");
            xb_add(&bar[XB_XGEN(b.x)], 1u);
            asm volatile("s_waitcnt vmcnt(0)" ::: "memory");
        } else {
            XB_SPIN(xb_ld(&bar[XB_XGEN(b.x)]) == gen, bar);
            __builtin_amdgcn_fence(__ATOMIC_ACQUIRE, "agent");
            asm volatile("s_waitcnt vmcnt(0)" ::: "memory");
        }
    }
    __syncthreads();
}

#define TID_OPAQUE() ({ int t_ = (int)threadIdx.x; asm volatile("" : "+v"(t_)); t_; })
__device__ __forceinline__ void xconv_rows(const float* xp, const float* xs, bf16* XB, float* rs0, int rb, int re, int gwl, int ngw) {
    const int lane = TID_OPAQUE() & 63;
    for (int m = rb + 2 * gwl; m < re; m += 2 * ngw) {
        const f32x4* xr0 = (const f32x4*)(m < NP ? xp + (size_t)m * D : xs + (size_t)(m - NP) * D) + lane; const f32x4* xr1 = xr0 + D / 4;
        f32x4 v[8]; float s0 = 0.f, s1 = 0.f;
#pragma unroll
        for (int j = 0; j < 4; ++j) { v[j] = __builtin_nontemporal_load(xr0 + 64 * j); v[4 + j] = __builtin_nontemporal_load(xr1 + 64 * j); }
#pragma unroll
        for (int j = 0; j < 4; ++j) { s0 += (v[j].x * v[j].x + v[j].y * v[j].y) + (v[j].z * v[j].z + v[j].w * v[j].w); s1 += (v[4 + j].x * v[4 + j].x + v[4 + j].y * v[4 + j].y) + (v[4 + j].z * v[4 + j].z + v[4 + j].w * v[4 + j].w); }
        s0 = wave_sum(s0); s1 = wave_sum(s1);
        if (lane == 0) { rs0[m] = 1.0f / sqrtf(s0 * (1.0f / D) + EPS); rs0[m + 1] = 1.0f / sqrtf(s1 * (1.0f / D) + EPS); }
        u32x2* o8 = (u32x2*)(XB + (size_t)m * D) + lane;
#pragma unroll
        for (int j = 0; j < 4; ++j) { u32x2 w; w.x = pk2(v[j].x, v[j].y); w.y = pk2(v[j].z, v[j].w); o8[64 * j] = w; u32x2 w1; w1.x = pk2(v[4 + j].x, v[4 + j].y); w1.y = pk2(v[4 + j].z, v[4 + j].w); o8[D / 4 + 64 * j] = w1; }
    }
}
__device__ __forceinline__ void pool_quads(const bf16* Z, const bf16* HB, bf16* MIX, int qb, int qe, int gwl, int ngw) {
    const int lane = TID_OPAQUE() & 63;
    const int nq = qe - qb, q0 = qb + (int)(((long)gwl * nq) / ngw), q1 = qb + (int)(((long)(gwl + 1) * nq) / ngw);
    const int c = lane * 8, w = 2 << (lane >> 4);
    for (int q = q0; q < q1; ++q) {
        const int m = 4 * q; const bool samp = m >= NP; const int t0 = samp ? ((m - NP) & (DSEQ - 1)) : (m & (SEQ - 1)); const int sidx = samp ? ((m - NP) >> 6) : 0;
        u32x4 L[19];
#pragma unroll
        for (int j = 0; j < 19; ++j) {
            const int tj = t0 - 15 + j;
            const bf16* p = (tj >= 0) ? Z + (size_t)(m - 15 + j) * INW + c : (samp ? HB + (size_t)(sidx * HIST + HIST + tj) * PW + c : Z + (size_t)m * INW + c);
            L[j] = *(const u32x4*)p;
        }
        float sum[4][8];
#pragma unroll
        for (int r = 0; r < 4; ++r)
#pragma unroll
            for (int e = 0; e < 8; ++e) sum[r][e] = 0.f;
#pragma unroll
        for (int j = 0; j < 19; ++j) {
            const bool valid = (t0 - 15 + j >= 0) || samp;
            const u32x4 r4 = L[j];
            float f[8] = {bflo(r4.x), bfhi(r4.x), bflo(r4.y), bfhi(r4.y), bflo(r4.z), bfhi(r4.z), bflo(r4.w), bfhi(r4.w)};
#pragma unroll
            for (int e = 0; e < 8; ++e) f[e] = valid ? f[e] : 0.f;
#pragma unroll
            for (int r = 0; r < 4; ++r) { const int k = 15 + r - j;
                if (k >= 0 && k <= 15) {
#pragma unroll
                    for (int e = 0; e < 8; ++e) sum[r][e] += (k < w) ? f[e] : 0.f;
                } }
        }
#pragma unroll
        for (int r = 0; r < 4; ++r) {
            const int cnt = samp ? w : ((t0 + r + 1 < w) ? t0 + r + 1 : w); const float inv = 1.0f / (float)cnt;
            const u32x4 a4 = L[15 + r];
            u32x4 o; o.x = pk2(sum[r][0] * inv - bflo(a4.x), sum[r][1] * inv - bfhi(a4.x)); o.y = pk2(sum[r][2] * inv - bflo(a4.y), sum[r][3] * inv - bfhi(a4.y));
            o.z = pk2(sum[r][4] * inv - bflo(a4.z), sum[r][5] * inv - bfhi(a4.z)); o.w = pk2(sum[r][6] * inv - bflo(a4.w), sum[r][7] * inv - bfhi(a4.w));
            *(u32x4*)(MIX + (size_t)(m + r) * D + c) = o;
        }
    }
}
__device__ __forceinline__ void gmlp_units(const bf16* Z, const bf16* Wm, const float* gb, bf16* MIX, LAS unsigned char* lds, int ub, int ue, int cb, int nb, int wave) {
    const int tid = TID_OPAQUE(), lane = tid & 63;
    for (int unit = ub + cb; unit < ue; unit += nb) {
        const int g = unit & 3, ch = unit >> 2; int m0, L;
        if (ch < 256) { m0 = ch * 128; L = 128; } else { m0 = NP + (ch - 256) * 64; L = 64; }
        const bf16* vsrc = Z + (size_t)m0 * INW + 1024 + g * 128;
        const int lp = (L == 128) ? 6 : 5;
        for (int item = tid; item < (16 << lp); item += 512) {
            const int pr = item & ((1 << lp) - 1), chunk = item >> lp;
            const u32x4 r0 = *(const u32x4*)(vsrc + (size_t)(2 * pr) * INW + chunk * 8), r1 = *(const u32x4*)(vsrc + (size_t)(2 * pr + 1) * INW + chunk * 8);
            LAS unsigned* vt = (LAS unsigned*)(lds + (chunk * 8) * 272 + pr * 4);
#pragma unroll
            for (int e2 = 0; e2 < 4; ++e2) { vt[(2 * e2) * 68] = (r0[e2] & 0xffffu) | (r1[e2] << 16); vt[(2 * e2 + 1) * 68] = (r0[e2] >> 16) | (r1[e2] & 0xffff0000u); }
        }
        __syncthreads();
        if (wave < (L >> 4)) {
            const int nk = (wave < 4) ? 2 : 4, iloc = wave * 16 + (lane & 15), kq = lane >> 4;
            const bf16* wrow = Wm + (size_t)(g * 128 + iloc) * 128 + kq * 8;
            f32x4 acc[8];
#pragma unroll
            for (int mt = 0; mt < 8; ++mt) acc[mt] = (f32x4){0.f, 0.f, 0.f, 0.f};
            for (int ks = 0; ks < nk; ++ks) {
                const bf16x8 bfrag = *(const bf16x8*)(wrow + ks * 32);
#pragma unroll
                for (int mt = 0; mt < 8; ++mt) {
                    const bf16x8 afrag = *(const LAS bf16x8*)(lds + (mt * 16 + (lane & 15)) * 272 + (ks * 32 + kq * 8) * 2);
                    acc[mt] = __builtin_amdgcn_mfma_f32_16x16x32_bf16(afrag, bfrag, acc[mt], 0, 0, 0);
                }
            }
            const int m = m0 + iloc; const float bias = gb[g * 128 + iloc];
            const bf16* urow = Z + (size_t)m * INW + 512 + g * 128 + 4 * kq; bf16* orow = MIX + (size_t)m * D + 512 + g * 128 + 4 * kq;
#pragma unroll
            for (int mt = 0; mt < 8; ++mt) {
                const u32x2 uu = *(const u32x2*)(urow + mt * 16);
                u32x2 o; o.x = pk2(bflo(uu.x) * (acc[mt][0] + bias), bfhi(uu.x) * (acc[mt][1] + bias)); o.y = pk2(bflo(uu.y) * (acc[mt][2] + bias), bfhi(uu.y) * (acc[mt][3] + bias));
                *(u32x2*)(orow + mt * 16) = o;
            }
        }
        __syncthreads();
    }
}
__device__ __forceinline__ void final_rows(float* out, const bf16* X2B, const bf16* XB1, const float* PART, const float* gf, int rb, int re, int gwl, int ngw) {
    const int lane = TID_OPAQUE() & 63;
    f32x4 gg[4];
#pragma unroll
    for (int j = 0; j < 4; ++j) gg[j] = ((const f32x4*)gf)[lane + 64 * j];
    for (int m = rb + 2 * gwl; m < re; m += 2 * ngw) {
        f32x4* xr = (f32x4*)(out + (size_t)m * D) + lane;
        f32x4 v[8]; float s0 = 0.f, s1 = 0.f;
        const u32x2* xb = (const u32x2*)((m < NP ? X2B : XB1) + (size_t)m * D) + lane;
#pragma unroll
        for (int j = 0; j < 4; ++j) { const u32x2 r0 = __builtin_nontemporal_load(xb + 64 * j), r1 = __builtin_nontemporal_load(xb + D / 4 + 64 * j);
            v[j] = (f32x4){bflo(r0.x), bfhi(r0.x), bflo(r0.y), bfhi(r0.y)}; v[4 + j] = (f32x4){bflo(r1.x), bfhi(r1.x), bflo(r1.y), bfhi(r1.y)}; }
        if (m >= NP) {
            const f32x4* pp = (const f32x4*)(PART + (size_t)(m - NP) * D) + lane;
#pragma unroll 2
            for (int ks = 0; ks < 16; ++ks) {
#pragma unroll
                for (int j = 0; j < 4; ++j) { v[j] += pp[(size_t)ks * (NS * D / 4) + 64 * j]; v[4 + j] += pp[(size_t)ks * (NS * D / 4) + D / 4 + 64 * j]; }
            }
        }
#pragma unroll
        for (int j = 0; j < 4; ++j) { s0 += (v[j].x * v[j].x + v[j].y * v[j].y) + (v[j].z * v[j].z + v[j].w * v[j].w); s1 += (v[4 + j].x * v[4 + j].x + v[4 + j].y * v[4 + j].y) + (v[4 + j].z * v[4 + j].z + v[4 + j].w * v[4 + j].w); }
        s0 = wave_sum(s0); s1 = wave_sum(s1);
        const float r0 = 1.0f / sqrtf(s0 * (1.0f / D) + EPS), r1 = 1.0f / sqrtf(s1 * (1.0f / D) + EPS);
#pragma unroll
        for (int j = 0; j < 4; ++j) { __builtin_nontemporal_store(v[j] * r0 * gg[j], xr + 64 * j); __builtin_nontemporal_store(v[4 + j] * r1 * gg[j], xr + D / 4 + 64 * j); }
    }
}

struct Args { const float* in[14]; float* out; unsigned char* ws; };

__global__ void __launch_bounds__(512, 2) fwd_megakernel(Args a) {
    extern __shared__ __attribute__((aligned(16))) unsigned char lds_raw[];
    LAS unsigned char* lds = (LAS unsigned char*)lds_raw;
    const int wave = __builtin_amdgcn_readfirstlane((int)threadIdx.x >> 6);
    const int G = gridDim.x, bx = blockIdx.x, gw = bx * 8 + wave, NGW = G * 8;
    const float *xp = a.in[0], *xs = a.in[1], *spool = a.in[2], *g1 = a.in[3], *w_in = a.in[4], *pool_w = a.in[5], *pool_scale = a.in[6], *gws = a.in[7], *gb = a.in[8],
                *w_out = a.in[9], *g2 = a.in[10], *w_up = a.in[11], *w_down = a.in[12], *gf = a.in[13];
    float* out = a.out; unsigned char* ws = a.ws;
    bf16 *XB = (bf16*)(ws + WS_XB), *Z = (bf16*)(ws + WS_Z), *MIX = (bf16*)(ws + WS_MIX), *XB1 = (bf16*)(ws + WS_XB1), *H = (bf16*)(ws + WS_H);
    bf16 *WinT = (bf16*)(ws + WS_WIN), *WoT = (bf16*)(ws + WS_WO), *WupT = (bf16*)(ws + WS_WUP), *WdT = (bf16*)(ws + WS_WDN), *Wm = (bf16*)(ws + WS_WM);
    float *rs0 = (float*)(ws + WS_RS0), *ssq1 = (float*)(ws + WS_SSQ1); bf16* HB = (bf16*)(ws + WS_HB); float* PART = (float*)(ws + WS_PART); bf16* X2B = (bf16*)(ws + WS_X2B);
    if (threadIdx.x < 2) ((volatile LAS unsigned*)(lds + BARST_OFF))[threadIdx.x] = 0u;
    __syncthreads();
    (void)xcd_barrier_post((unsigned*)(ws + WS_CTL), (volatile LAS unsigned*)(lds + BARST_OFF));
#define GRID_BAR() do { XcdBarrier b_; b_.bar = (unsigned*)(a.ws + WS_CTL); b_.x = xb_xcc_id(); b_.st = (volatile LAS unsigned*)(lds + BARST_OFF); xcd_barrier(b_); } while (0)
    const int S1 = G >= 48 ? 24 : G / 2, S3 = G >= 32 ? 16 : G / 2, S4 = G >= 128 ? 64 : G / 2;
    LAS unsigned char* scr = lds + wave * 16384;
    constexpr int I_IN = (D / 32) * (INW / 128), I_OUT = (512 / 32) * (D / 128), I_UP = (D / 32) * (FF / 128), I_DN = (FF / 32) * (D / 128), I_FOLD = 4 * 16 * 16;

    {
    const int tid = TID_OPAQUE(), lane = tid & 63;
    for (int it = gw; it < I_IN; it += NGW) p0_transpose_item(w_in, INW, g1, WinT, D, 0, scr, it, lane);
    for (int i = bx * 512 + tid; i < 4 * 128 * 128; i += G * 512) { const int ii = (i >> 7) & 127, jj = i & 127; Wm[i] = (bf16)(((jj >> 6) <= (ii >> 6)) ? f2bf(gws[i]) : 0u); }
    for (int i = bx * 512 + tid; i < M; i += G * 512) ssq1[i] = 0.f;
    for (int i = bx * 512 + tid; i < 16 * HIST * PW / 2; i += G * 512) ((unsigned*)HB)[i] = pk2(spool[2 * i], spool[2 * i + 1]);
    }
    xconv_rows(xp, xs, XB, rs0, NP, M, gw, NGW);
    {
        unsigned* cnt0 = (unsigned*)(a.ws + WS_CTL) + 3840;
        asm volatile("s_waitcnt vmcnt(0)" ::: "memory"); __syncthreads();
        if (threadIdx.x == 0) {
            __builtin_amdgcn_fence(__ATOMIC_RELEASE, "agent"); asm volatile("s_waitcnt vmcnt(0)" ::: "memory");
            (void)xb_add(cnt0, 1u);
            if (bx < S1) {
                unsigned sp = 0; while (xb_ld(cnt0) < (unsigned)G) { __builtin_amdgcn_s_sleep(2); if (++sp > (1u << 22)) break; }
                __builtin_amdgcn_fence(__ATOMIC_ACQUIRE, "agent"); asm volatile("s_waitcnt vmcnt(0)" ::: "memory");
            }
        }
        __syncthreads();
    }

    if (bx < S1) {
        pg8::Gemm g{XB, WinT, M, INW, D}; pg8::StaticOrder S; S.init(NS, INW, D, S1, bx); S.pm_base = NP / 256;
        EpiIn E{Z, rs0, out};
        pg8::gemm_phase<EpiIn, pg8::StaticOrder, true, true>(lds, g, S, E);
        asm volatile("s_waitcnt vmcnt(0)" ::: "memory"); __syncthreads();
        if (threadIdx.x == 0) {
            unsigned* cnt = (unsigned*)(a.ws + WS_CTL) + 3600;
            __builtin_amdgcn_fence(__ATOMIC_RELEASE, "agent"); asm volatile("s_waitcnt vmcnt(0)" ::: "memory");
            (void)xb_add(cnt, 1u);
            unsigned sp = 0; while (xb_ld(cnt) < (unsigned)S1) { __builtin_amdgcn_s_sleep(2); if (++sp > (1u << 22)) break; }
            __builtin_amdgcn_fence(__ATOMIC_ACQUIRE, "agent"); asm volatile("s_waitcnt vmcnt(0)" ::: "memory");
        }
        __syncthreads();
        pool_quads(Z, HB, MIX, NP / 4, M / 4, gw, S1 * 8);
        gmlp_units(Z, Wm, gb, MIX, lds, 1024, 1088, bx, S1, wave);
    } else {
        const int gwl = (bx - S1) * 8 + wave, ngw = (G - S1) * 8; const int lane = TID_OPAQUE() & 63;
        constexpr int NITEMS = I_OUT + I_UP + I_DN + I_FOLD;
        for (int rep = 0; rep < ((PROBE == 22 || PROBE == 23) ? 2 : 1); ++rep)
        for (int it = gwl; it < NITEMS; it += ngw) {
            int r = it;
            if (PROBE == 22 && rep == 1 && r >= I_OUT + I_UP + I_DN) continue;
            if (PROBE == 23 && rep == 1 && r < I_OUT + I_UP + I_DN) continue;
            if (r < I_OUT) { p0_transpose_item(w_out + (size_t)512 * D, D, nullptr, WoT, D, 512, scr, r, lane); continue; } r -= I_OUT;
            if (r < I_UP) { p0_transpose_item(w_up, FF, g2, WupT, D, 0, scr, r, lane); continue; } r -= I_UP;
            if (r < I_DN) { p0_transpose_item(w_down, D, nullptr, WdT, FF, 0, scr, r, lane); continue; } r -= I_DN;
            const int g = r >> 8, c0 = ((r >> 4) & 15) * 8, n = (r & 15) * 64 + lane;
            float acc[8];
#pragma unroll
            for (int c = 0; c < 8; ++c) acc[c] = 0.f;
            const float* pw = pool_w + (size_t)(g * 128 + c0) * 128;
            for (int e0 = 0; e0 < 128; e0 += 16) {
                float wv[16];
#pragma unroll
                for (int e = 0; e < 16; ++e) wv[e] = w_out[(size_t)(g * 128 + e0 + e) * D + n];
#pragma unroll
                for (int e = 0; e < 16; ++e) { const float ws_ = wv[e] * pool_scale[g * 128 + e0 + e];
#pragma unroll
                    for (int c = 0; c < 8; ++c) acc[c] += pw[c * 128 + e0 + e] * ws_; }
            }
            u32x4 o; o.x = pk2(acc[0], acc[1]); o.y = pk2(acc[2], acc[3]); o.z = pk2(acc[4], acc[5]); o.w = pk2(acc[6], acc[7]);
            *(u32x4*)(WoT + (size_t)n * D + g * 128 + c0) = o;
        }
        xconv_rows(xp, xs, XB, rs0, 0, NP, gwl, ngw);
        if (PROBE == 21) xconv_rows(xp, xs, XB, rs0, 0, NP, gwl, ngw);
    }
    GRID_BAR();

    {
        pg8::Gemm g{XB, WinT, M, INW, D}; pg8::StaticOrder S; S.init(NP, INW, D, G, bx);
        EpiIn E{Z, rs0, out};
        pg8::gemm_phase<EpiIn, pg8::StaticOrder, true, true>(lds, g, S, E);
    }
    GRID_BAR();

    if (bx < S3) {
        pg8::Gemm g{MIX, WoT, M, D, D}; pg8::StaticOrder S; S.init(NS, D, D, S3, bx); S.pm_base = NP / 256;
        EpiOut E{XB, XB1, ssq1};
        pg8::gemm_phase<EpiOut, pg8::StaticOrder, true, true>(lds, g, S, E);
    } else {
        pool_quads(Z, HB, MIX, 0, NP / 4, (bx - S3) * 8 + wave, (G - S3) * 8);
        gmlp_units(Z, Wm, gb, MIX, lds, 0, 1024, bx - S3, G - S3, wave);
    }
    GRID_BAR();

    {
        pg8::Gemm g{MIX, WoT, M, D, D}; pg8::StaticOrder S; S.init(NP, D, D, G, bx);
        EpiOut E{XB, XB1, ssq1};
        pg8::gemm_phase<EpiOut, pg8::StaticOrder, true, true>(lds, g, S, E);
    }
    GRID_BAR();

    {
        pg8::Gemm g{XB1, WupT, M, FF, D}; pg8::StaticOrder S; S.init(NP, FF, D, G, bx);
        EpiUp E{H, ssq1};
        pg8::gemm_phase<EpiUp, pg8::StaticOrder, true, true>(lds, g, S, E);
    }
    GRID_BAR();

    {
        pg8::Gemm g{H, WdT, M, D, FF}; pg8::StaticOrder S; S.init(NP, D, FF, G, bx);
        EpiDown E{XB1, X2B, PART};
        pg8::gemm_phase<EpiDown, pg8::StaticOrder, true, true>(lds, g, S, E);
    }
    GRID_BAR();

    if (bx < S4) {
        pg8::Gemm g{XB1, WupT, M, FF, D}; pg8::StaticOrder S; S.init(NS, FF, D, S4, bx); S.pm_base = NP / 256;
        EpiUp E{H, ssq1};
        pg8::gemm_phase<EpiUp, pg8::StaticOrder, true, true>(lds, g, S, E);
    } else {
        final_rows(out, X2B, XB1, PART, gf, 0, NP, (bx - S4) * 8 + wave, (G - S4) * 8);
    }
    GRID_BAR();

    {
        pg8::Gemm g{H, WdT, M, D, FF}; SampleDownOrder S; S.init(G, bx);
        EpiDown E{XB1, X2B, PART};
        pg8::gemm_phase<EpiDown, SampleDownOrder, true, true>(lds, g, S, E);
    }
    GRID_BAR();

    if (PROBE == 7) { for (int k = 0; k < 10; ++k) GRID_BAR(); }
    final_rows(out, X2B, XB1, PART, gf, NP, M, gw, NGW);
}

extern "C" void kernel_launch(void* const* d_in, const int* in_sizes, int n_in, void* d_out, int out_size, void* d_ws, size_t ws_size, hipStream_t stream) {
    static int grid = 0;
    if (grid == 0) {
        if (n_in != 14 || in_sizes[0] != NP * D || in_sizes[1] != NS * D || (size_t)out_size != O_END || ws_size < WS_END) {
            fprintf(stderr, "kernel_launch: unexpected shapes (n_in %d in0 %d out %d ws %zu)\n", n_in, n_in > 0 ? in_sizes[0] : -1, out_size, ws_size); grid = -1; return; }
        int dev = 0, cus = 0, per_cu = 0;
        if (hipGetDevice(&dev) != hipSuccess || hipDeviceGetAttribute(&cus, hipDeviceAttributeMultiprocessorCount, dev) != hipSuccess) { grid = -1; return; }
        if (hipFuncSetAttribute((const void*)fwd_megakernel, hipFuncAttributeMaxDynamicSharedMemorySize, LDS_BYTES) != hipSuccess) { fprintf(stderr, "kernel_launch: hipFuncSetAttribute failed\n"); grid = -1; return; }
        if (hipOccupancyMaxActiveBlocksPerMultiprocessor(&per_cu, (const void*)fwd_megakernel, 512, LDS_BYTES) != hipSuccess || per_cu < 1) { fprintf(stderr, "kernel_launch: occupancy query gave %d\n", per_cu); (void)hipGetLastError(); per_cu = 1; }
        grid = cus * per_cu;
    }
    if (grid < 0) return;
    if (hipMemsetAsync((char*)d_ws + WS_CTL, 0, CTL_ZERO_BYTES, stream) != hipSuccess) { fprintf(stderr, "kernel_launch: memset failed\n"); return; }
    Args a{};
    for (int i = 0; i < 14; ++i) a.in[i] = (const float*)d_in[i];
    a.out = (float*)d_out; a.ws = (unsigned char*)d_ws;
    void* args[] = {&a};
    const hipError_t e = hipLaunchCooperativeKernel((const void*)fwd_megakernel, dim3(grid), dim3(512), args, LDS_BYTES, stream);
    if (e != hipSuccess) fprintf(stderr, "kernel_launch: cooperative launch failed: %s (grid %d)\n", hipGetErrorString(e), grid);
}
```

```cpp
#include <hip/hip_runtime.h>
#include <cstdio>
#include <cstdint>
namespace pg8 {
#define PG8_LAS __attribute__((address_space(3)))
typedef unsigned short bf16_t;
typedef short bf16x8 __attribute__((ext_vector_type(8)));
typedef float f32x4 __attribute__((ext_vector_type(4)));
typedef unsigned u32x4 __attribute__((ext_vector_type(4)));
constexpr int BM = 256, BK = 64, HALF = 128, HTB = HALF * BK * 2  , STAGE_BYTES = 8 * HTB, NXCD = 8, WGM = 4;

__host__ __device__ __forceinline__ int lds_byte(int r, int c) { const int st = (r >> 4) * 2 + (c >> 5), rr = r & 15, cc = c & 31, ob = rr * 64 + cc * 2; return st * 1024 + (ob ^ (((ob >> 9) & 1) << 5)); }
__host__ __device__ __forceinline__ void stage_rc(int b, int& R, int& C) { const int st = b / 1024, sb = b % 1024, swz = sb ^ (((sb >> 9) & 1) << 5); R = (st >> 1) * 16 + swz / 64; C = (st & 1) * 32 + (swz % 64) / 2; }
__host__ __device__ __forceinline__ int perm32(int rho) { const int n = rho >> 4, i = rho & 15; return 8 * (i >> 2) + 4 * n + (i & 3); }

struct Unit { int pm, pn, k0, nt; };
struct Gemm { const bf16_t* A; const bf16_t* Bt; int M, N, K; };

struct StaticOrder {
    int nM, nN, nwg, G, c, nt0, pm_base;
    __host__ __device__ void init(int M, int N, int K, int G_, int c_) { nM = M / BM; nN = N / BM; nwg = nM * nN; G = G_; c = c_; nt0 = K / BK; pm_base = 0; }
    __host__ __device__ bool next(int i, Unit& u) const {
        const long L = (long)i * G + c; if (L >= nwg) return false;
        int wgid = (int)L; { const int q = nwg / NXCD, r = nwg % NXCD, xcd = wgid % NXCD, off = wgid / NXCD; wgid = (xcd < r ? xcd * (q + 1) : r * (q + 1) + (xcd - r) * q) + off; }
        const int nig = WGM * nN, gid = wgid / nig, fm = gid * WGM, gsz = (nM - fm) < WGM ? (nM - fm) : WGM;
        u.pm = pm_base + fm + ((wgid % nig) % gsz); u.pn = (wgid % nig) / gsz; u.k0 = 0; u.nt = nt0; return true;
    }
    __device__ __forceinline__ void a_ready(const Unit&) const {}
    __device__ __forceinline__ void done(const Unit&) const {}
};

__device__ __forceinline__ unsigned cvt_pk_bf16(float lo, float hi) { unsigned r; asm volatile("v_cvt_pk_bf16_f32 %0, %1, %2" : "=v"(r) : "v"(lo), "v"(hi)); return r; }
typedef float f32x2 __attribute__((ext_vector_type(2)));
__device__ __forceinline__ f32x2 gelu_pk(f32x2 v) {
    const f32x2 av = __builtin_elementwise_abs(v), d = av * 0.2316418882f + 1.0f;
    f32x2 t; t.x = __builtin_amdgcn_rcpf(d.x); t.y = __builtin_amdgcn_rcpf(d.y);
    f32x2 q = t * 0.5307027145f + (-0.7265760135f); q = q * t + 0.7107068705f; q = q * t + (-0.142248368f); q = q * t + 0.127414796f; q = q * t;
    const f32x2 s = (v * v) * (-0.72134752044f);
    f32x2 e; e.x = __builtin_amdgcn_exp2f(s.x); e.y = __builtin_amdgcn_exp2f(s.y);
    const f32x2 m = v * (q * e), r = v - m;
    f32x2 o; o.x = v.x < 0.f ? m.x : r.x; o.y = v.y < 0.f ? m.y : r.y; return o;
}

template <class Epi, class Sched, bool ALIGN_EPI = false, bool SP2 = false>
__device__ __forceinline__ void gemm_phase(PG8_LAS unsigned char* lds, const Gemm g, const Sched& S, const Epi& E) {
    const int tid = threadIdx.x, wid = __builtin_amdgcn_readfirstlane(tid >> 6), lane = tid & 63, wr = wid >> 2, wc = wid & 3, fr = lane & 15, fq = lane >> 4;
    const int K = g.K;
    unsigned voffA[2], voffB[2];
#pragma unroll
    for (int i = 0; i < 2; ++i) { int R, C; stage_rc(tid * 16 + i * 8192, R, C); const int Rb = Epi::PERM ? ((R & ~31) + perm32(R & 31)) : R;
        voffA[i] = (unsigned)(R * K + C) * 2u; voffB[i] = (unsigned)(Rb * K + C) * 2u; }
    const size_t kstep = (size_t)(BK * 2);
    const size_t hstep = (size_t)HALF * K * 2;
    const size_t tstep = 2 * hstep;
    const unsigned ldsw = (unsigned)wid * 1024u;
    const int aoff = lds_byte(wr * 64 + fr, fq * 8), boff = lds_byte(wc * 32 + fr, fq * 8);
#define PG8_SA(b, h) (((b) * 2 + (h)) * HTB)
#define PG8_SB(b, h) ((4 + (b) * 2 + (h)) * HTB)
#define PG8_STAGE(bufoff, gbase, voff) do { _Pragma("unroll") for (int _i = 0; _i < 2; ++_i) \
        __builtin_amdgcn_global_load_lds((const unsigned*)((const char*)(gbase) + (voff)[_i]), (PG8_LAS unsigned*)(lds + (bufoff) + ldsw + _i * 8192), 16, 0, 0); } while (0)
#define PG8_LDA(dst, b, h) do { _Pragma("unroll") for (int m = 0; m < 4; ++m) _Pragma("unroll") for (int k = 0; k < 2; ++k) dst[m][k] = *(const PG8_LAS bf16x8*)(lds + PG8_SA(b, h) + aoff + m * 2048 + k * 1024); } while (0)
#define PG8_LDB(dst, b, h) do { _Pragma("unroll") for (int n = 0; n < 2; ++n) _Pragma("unroll") for (int k = 0; k < 2; ++k) dst[n][k] = *(const PG8_LAS bf16x8*)(lds + PG8_SB(b, h) + boff + n * 2048 + k * 1024); } while (0)
#define PG8_MMA(ai, bj, At, Bt) do { __builtin_amdgcn_s_setprio(1); _Pragma("unroll") for (int m = 0; m < 4; ++m) _Pragma("unroll") for (int n = 0; n < 2; ++n) _Pragma("unroll") for (int k = 0; k < 2; ++k) \
        acc[ai][bj][m][n] = __builtin_amdgcn_mfma_f32_16x16x32_bf16(Bt[n][k], At[m][k], acc[ai][bj][m][n], 0, 0, 0); __builtin_amdgcn_s_setprio(0); } while (0)
#define PG8_WAIT_V(n) asm volatile("s_waitcnt vmcnt(" #n ")" ::: "memory")
#define PG8_WAIT_L(n) asm volatile("s_waitcnt lgkmcnt(" #n ")" ::: "memory")
#define PG8_BAR __builtin_amdgcn_s_barrier()
#define PG8_SCHED __builtin_amdgcn_sched_barrier(0)
    Unit cur, nxt; int ui = 0;
    if (!S.next(0, cur)) return;
    f32x4 acc[2][2][4][2];
#pragma unroll
    for (int a = 0; a < 2; ++a)
#pragma unroll
        for (int b = 0; b < 2; ++b)
#pragma unroll
            for (int m = 0; m < 4; ++m)
#pragma unroll
                for (int n = 0; n < 2; ++n) acc[a][b][m][n] = (f32x4){0.f, 0.f, 0.f, 0.f};
    bf16x8 At[4][2], B0[2][2], B1[2][2];
    const char* cA = (const char*)g.A + (size_t)cur.pm * tstep + (size_t)cur.k0 * 2; const char* cB = (const char*)g.Bt + (size_t)cur.pn * tstep + (size_t)cur.k0 * 2;
    S.a_ready(cur);
    if constexpr (SP2) {
        PG8_STAGE(PG8_SB(0, 0), cB, voffB); PG8_STAGE(PG8_SB(0, 1), cB + hstep, voffB); PG8_STAGE(PG8_SA(0, 0), cA, voffA); PG8_STAGE(PG8_SA(0, 1), cA + hstep, voffA);
        if (wr == 1) PG8_BAR;
        PG8_WAIT_V(2); PG8_BAR;
        PG8_STAGE(PG8_SB(1, 0), cB + kstep, voffB); PG8_STAGE(PG8_SA(1, 0), cA + kstep, voffA); PG8_STAGE(PG8_SB(1, 1), cB + hstep + kstep, voffB);
        PG8_WAIT_V(6); PG8_BAR;
    } else {
        PG8_STAGE(PG8_SB(0, 0), cB, voffB); PG8_STAGE(PG8_SA(0, 0), cA, voffA); PG8_STAGE(PG8_SB(0, 1), cB + hstep, voffB); PG8_STAGE(PG8_SA(0, 1), cA + hstep, voffA);
        if (wr == 1) PG8_BAR;
        PG8_WAIT_V(4); PG8_BAR;
        PG8_STAGE(PG8_SB(1, 0), cB + kstep, voffB); PG8_STAGE(PG8_SA(1, 0), cA + kstep, voffA); PG8_STAGE(PG8_SB(1, 1), cB + hstep + kstep, voffB);
        PG8_WAIT_V(6); PG8_BAR;
    }
    for (;;) {
        const bool has_next = S.next(ui + 1, nxt);
        const char* nA = has_next ? (const char*)g.A + (size_t)nxt.pm * tstep + (size_t)nxt.k0 * 2 : cA; const char* nB = has_next ? (const char*)g.Bt + (size_t)nxt.pn * tstep + (size_t)nxt.k0 * 2 : cB;
        const int nt = cur.nt;
        for (int t = 0; t < nt; t += 2) {
            const bool last = (t == nt - 2);
            const char* a1 = cA + (size_t)(t + 1) * kstep;
            const char* a2 = last ? nA : cA + (size_t)(t + 2) * kstep; const char* b2 = last ? nB : cB + (size_t)(t + 2) * kstep;
            const char* a3 = a2 + kstep; const char* b3 = b2 + kstep;
            if (last && has_next) S.a_ready(nxt);
            if constexpr (SP2) {
            PG8_LDB(B0, 0, 0); PG8_LDB(B1, 0, 1); PG8_SCHED; PG8_LDA(At, 0, 0); PG8_STAGE(PG8_SA(1, 1), a1 + hstep, voffA);
            PG8_WAIT_V(8); PG8_WAIT_L(0); PG8_BAR; PG8_MMA(0, 0, At, B0); PG8_MMA(0, 1, At, B1); PG8_BAR; PG8_SCHED;
            PG8_LDA(At, 0, 1); PG8_STAGE(PG8_SB(0, 0), b2, voffB); PG8_STAGE(PG8_SB(0, 1), b2 + hstep, voffB); PG8_STAGE(PG8_SA(0, 0), a2, voffA);
            PG8_WAIT_V(8); PG8_WAIT_L(0); PG8_BAR; PG8_MMA(1, 0, At, B0); PG8_MMA(1, 1, At, B1); PG8_BAR; PG8_SCHED;
            PG8_LDB(B0, 1, 0); PG8_LDB(B1, 1, 1); PG8_SCHED; PG8_LDA(At, 1, 0); PG8_STAGE(PG8_SA(0, 1), a2 + hstep, voffA);
            PG8_WAIT_V(8); PG8_WAIT_L(0); PG8_BAR; PG8_MMA(0, 0, At, B0); PG8_MMA(0, 1, At, B1); PG8_BAR; PG8_SCHED;
            PG8_LDA(At, 1, 1); PG8_STAGE(PG8_SB(1, 0), b3, voffB); PG8_STAGE(PG8_SB(1, 1), b3 + hstep, voffB); PG8_STAGE(PG8_SA(1, 0), a3, voffA);
            PG8_WAIT_V(8); PG8_WAIT_L(0); PG8_BAR; PG8_MMA(1, 0, At, B0); PG8_MMA(1, 1, At, B1); PG8_BAR; PG8_SCHED;
            } else {
            PG8_LDB(B0, 0, 0); PG8_SCHED; PG8_LDA(At, 0, 0); PG8_STAGE(PG8_SA(1, 1), a1 + hstep, voffA);
            PG8_WAIT_L(8); PG8_BAR; PG8_WAIT_L(0); PG8_MMA(0, 0, At, B0); PG8_BAR; PG8_SCHED;
            PG8_LDB(B1, 0, 1); PG8_STAGE(PG8_SB(0, 0), b2, voffB);
            PG8_BAR; PG8_WAIT_L(0); PG8_MMA(0, 1, At, B1); PG8_BAR;
            PG8_LDA(At, 0, 1); PG8_STAGE(PG8_SA(0, 0), a2, voffA);
            PG8_BAR; PG8_WAIT_L(0); PG8_MMA(1, 0, At, B0); PG8_BAR; PG8_SCHED;
            PG8_STAGE(PG8_SB(0, 1), b2 + hstep, voffB);
            PG8_WAIT_V(6); PG8_BAR; PG8_MMA(1, 1, At, B1); PG8_BAR;
            PG8_LDB(B0, 1, 0); PG8_SCHED; PG8_LDA(At, 1, 0); PG8_STAGE(PG8_SA(0, 1), a2 + hstep, voffA);
            PG8_WAIT_L(8); PG8_BAR; PG8_WAIT_L(0); PG8_MMA(0, 0, At, B0); PG8_BAR; PG8_SCHED;
            PG8_LDB(B1, 1, 1); PG8_STAGE(PG8_SB(1, 0), b3, voffB);
            PG8_BAR; PG8_WAIT_L(0); PG8_MMA(0, 1, At, B1); PG8_BAR;
            PG8_LDA(At, 1, 1); PG8_STAGE(PG8_SA(1, 0), a3, voffA);
            PG8_BAR; PG8_WAIT_L(0); PG8_MMA(1, 0, At, B0); PG8_BAR; PG8_SCHED;
            PG8_STAGE(PG8_SB(1, 1), b3 + hstep, voffB);
            PG8_WAIT_V(6); PG8_BAR; PG8_MMA(1, 1, At, B1); PG8_BAR;
            }
        }
        if constexpr (ALIGN_EPI) { if (wr == 0) PG8_BAR; }
        if constexpr (!Epi::AFTER_DRAIN) { E(acc, cur, wr, wc, fr, fq); S.done(cur); }
        if (!has_next) break;
#pragma unroll
        for (int a = 0; a < 2; ++a)
#pragma unroll
            for (int b = 0; b < 2; ++b)
#pragma unroll
                for (int m = 0; m < 4; ++m)
#pragma unroll
                    for (int n = 0; n < 2; ++n) acc[a][b][m][n] = (f32x4){0.f, 0.f, 0.f, 0.f};
        cur = nxt; cA = nA; cB = nB; ++ui;
        if constexpr (ALIGN_EPI) { if (wr == 1) PG8_BAR; }
    }
    PG8_WAIT_V(0);
    if constexpr (!ALIGN_EPI) { if (wr == 0) PG8_BAR; }
    PG8_BAR;
    if constexpr (Epi::AFTER_DRAIN) { E.fused(acc, cur, wr, wc, fr, fq, lds, wid, lane); S.done(cur); }
#undef PG8_SA
#undef PG8_SB
#undef PG8_STAGE
#undef PG8_LDA
#undef PG8_LDB
#undef PG8_MMA
#undef PG8_WAIT_V
#undef PG8_WAIT_L
#undef PG8_BAR
#undef PG8_SCHED
}
}
#define LAS __attribute__((address_space(3)))
#ifndef PROBE
#define PROBE 0
#endif
typedef unsigned short bf16;
typedef pg8::f32x4 f32x4;
typedef pg8::u32x4 u32x4;
typedef pg8::bf16x8 bf16x8;
typedef unsigned u32x2 __attribute__((ext_vector_type(2)));
constexpr int D = 1024, SEQ = 8192, NP = 4 * SEQ, DSEQ = 64, NS = 16 * DSEQ, M = NP + NS;
constexpr int INW = 1536, PW = 512, FF = 4096, HIST = 15;
constexpr float EPS = 1e-6f;
constexpr size_t O_SPP = (size_t)M * D, O_SPS = O_SPP + 4 * HIST * PW, O_VS = O_SPS + 16 * HIST * PW, O_END = O_VS + (size_t)NS * 512;
constexpr size_t MiB = 1u << 20;
constexpr size_t WS_H = 0;
constexpr size_t WS_XB = 0;
constexpr size_t WS_Z = 66 * MiB;
constexpr size_t WS_MIX = 165 * MiB;
constexpr size_t WS_XB1 = 264 * MiB;
constexpr size_t WS_WIN = 330 * MiB, WS_WO = 333 * MiB, WS_WUP = 335 * MiB, WS_WDN = 343 * MiB, WS_WM = 351 * MiB;
constexpr size_t WS_RS0 = 352 * MiB, WS_SSQ1 = 353 * MiB, WS_HB = 354 * MiB, WS_CTL = 355 * MiB, WS_PART = 356 * MiB, WS_X2B = 420 * MiB, WS_END = 486 * MiB;
constexpr size_t CTL_ZERO_BYTES = 16384;
constexpr int BARST_OFF = 131072 + 64;
constexpr int LDS_BYTES = 147456;

__device__ __forceinline__ unsigned f2bf(float f) { unsigned u = __builtin_bit_cast(unsigned, f); return (u + 0x7fffu + ((u >> 16) & 1u)) >> 16; }
__device__ __forceinline__ unsigned pk2(float lo, float hi) { return f2bf(lo) | (f2bf(hi) << 16); }
__device__ __forceinline__ float bflo(unsigned w) { return __builtin_bit_cast(float, w << 16); }
__device__ __forceinline__ float bfhi(unsigned w) { return __builtin_bit_cast(float, w & 0xffff0000u); }
__device__ __forceinline__ float wave_sum(float v) {
#pragma unroll
    for (int o = 1; o < 64; o <<= 1) v += __shfl_xor(v, o);
    return v;
}
__device__ __forceinline__ float gelu_tanh(float x) {
    const float y = x * (1.0f + 0.044715f * x * x);
    const float e = __builtin_amdgcn_exp2f(-2.302208198f * y);
    return x * __builtin_amdgcn_rcpf(1.0f + e);
}

struct EpiIn {
    static constexpr bool PERM = true, AFTER_DRAIN = false;
    bf16* Z; const float* rs0; float* out;
    __device__ __forceinline__ void operator()(const f32x4 (&acc)[2][2][4][2], const pg8::Unit& u, int wr, int wc, int fr, int fq) const {
        const int row0 = u.pm * 256 + wr * 64 + fr, col0 = u.pn * 256 + wc * 32 + 8 * fq, kind = u.pn >> 1;
        float sc[2][4];
#pragma unroll
        for (int ai = 0; ai < 2; ++ai)
#pragma unroll
            for (int m = 0; m < 4; ++m) sc[ai][m] = rs0[row0 + ai * 128 + m * 16];
#pragma unroll
        for (int ai = 0; ai < 2; ++ai)
#pragma unroll
            for (int m = 0; m < 4; ++m) {
                const int row = row0 + ai * 128 + m * 16; const float s = sc[ai][m];
                bf16* zr = Z + (size_t)row * INW + col0;
                float* side = nullptr;
                if (kind == 0) {
                    if (row < NP) { const int t = row & (SEQ - 1); if (t >= SEQ - HIST) side = out + O_SPP + (size_t)((row >> 13) * HIST + t - (SEQ - HIST)) * PW + col0; }
                    else { const int r2 = row - NP, t = r2 & (DSEQ - 1); if (t >= DSEQ - HIST) side = out + O_SPS + (size_t)((r2 >> 6) * HIST + t - (DSEQ - HIST)) * PW + col0; }
                } else if (kind == 2 && row >= NP) side = out + O_VS + (size_t)(row - NP) * 512 + (col0 - 1024);
#pragma unroll
                for (int bj = 0; bj < 2; ++bj) {
                    f32x4 v0 = acc[ai][bj][m][0] * s, v1 = acc[ai][bj][m][1] * s;
                    if (kind) {
#pragma unroll
                        for (int e = 0; e < 4; ++e) { v0[e] = gelu_tanh(v0[e]); v1[e] = gelu_tanh(v1[e]); }
                    }
                    u32x4 w; w.x = pg8::cvt_pk_bf16(v0[0], v0[1]); w.y = pg8::cvt_pk_bf16(v0[2], v0[3]); w.z = pg8::cvt_pk_bf16(v1[0], v1[1]); w.w = pg8::cvt_pk_bf16(v1[2], v1[3]);
                    *(u32x4*)(zr + bj * 128) = w;
                    if (side) { *(f32x4*)(side + bj * 128) = v0; *(f32x4*)(side + bj * 128 + 4) = v1; }
                }
            }
    }
};
struct EpiNone {
    static constexpr bool PERM = true, AFTER_DRAIN = false;
    float* sink;
    __device__ __forceinline__ void operator()(const f32x4 (&acc)[2][2][4][2], const pg8::Unit& u, int wr, int wc, int fr, int fq) const {
        f32x4 t = (f32x4){0.f, 0.f, 0.f, 0.f};
#pragma unroll
        for (int ai = 0; ai < 2; ++ai)
#pragma unroll
            for (int bj = 0; bj < 2; ++bj)
#pragma unroll
                for (int m = 0; m < 4; ++m) t += acc[ai][bj][m][0] + acc[ai][bj][m][1];
        if (t[0] + t[1] + t[2] + t[3] == 123.456f) sink[0] = t[0];
    }
};
struct EpiOut {
    static constexpr bool PERM = true, AFTER_DRAIN = false;
    const bf16* XB; bf16* XB1; float* ssq;
    __device__ __forceinline__ void operator()(const f32x4 (&acc)[2][2][4][2], const pg8::Unit& u, int wr, int wc, int fr, int fq) const {
        const int row0 = u.pm * 256 + wr * 64 + fr, col0 = u.pn * 256 + wc * 32 + 8 * fq;
#pragma unroll
        for (int ai = 0; ai < 2; ++ai) {
            u32x4 pre[4][2];
#pragma unroll
            for (int m = 0; m < 4; ++m)
#pragma unroll
                for (int bj = 0; bj < 2; ++bj) pre[m][bj] = *(const u32x4*)(XB + (size_t)(row0 + ai * 128 + m * 16) * D + col0 + bj * 128);
#pragma unroll
            for (int m = 0; m < 4; ++m) {
                const int row = row0 + ai * 128 + m * 16;
                bf16* brow = XB1 + (size_t)row * D + col0; float q = 0.f;
#pragma unroll
                for (int bj = 0; bj < 2; ++bj) {
                    const u32x4 r = pre[m][bj];
                    const f32x4 o0 = acc[ai][bj][m][0] + (f32x4){bflo(r.x), bfhi(r.x), bflo(r.y), bfhi(r.y)}, o1 = acc[ai][bj][m][1] + (f32x4){bflo(r.z), bfhi(r.z), bflo(r.w), bfhi(r.w)};
                    u32x4 w; w.x = pg8::cvt_pk_bf16(o0[0], o0[1]); w.y = pg8::cvt_pk_bf16(o0[2], o0[3]); w.z = pg8::cvt_pk_bf16(o1[0], o1[1]); w.w = pg8::cvt_pk_bf16(o1[2], o1[3]);
                    *(u32x4*)(brow + bj * 128) = w;
                    q += (o0[0] * o0[0] + o0[1] * o0[1]) + (o0[2] * o0[2] + o0[3] * o0[3]) + (o1[0] * o1[0] + o1[1] * o1[1]) + (o1[2] * o1[2] + o1[3] * o1[3]);
                }
                q += __shfl_xor(q, 16); q += __shfl_xor(q, 32);
                if (fq == 0) atomicAdd(ssq + row, q);
            }
            asm volatile("" ::: "memory");
        }
    }
};
struct EpiUp {
    static constexpr bool PERM = true, AFTER_DRAIN = false;
    bf16* H; const float* ssq;
    __device__ __forceinline__ void operator()(const f32x4 (&acc)[2][2][4][2], const pg8::Unit& u, int wr, int wc, int fr, int fq) const {
        const int row0 = u.pm * 256 + wr * 64 + fr, col0 = u.pn * 256 + wc * 32 + 8 * fq;
        float sc[2][4];
#pragma unroll
        for (int ai = 0; ai < 2; ++ai)
#pragma unroll
            for (int m = 0; m < 4; ++m) sc[ai][m] = ssq[row0 + ai * 128 + m * 16];
#pragma unroll
        for (int ai = 0; ai < 2; ++ai)
#pragma unroll
            for (int m = 0; m < 4; ++m) {
                const int row = row0 + ai * 128 + m * 16; const float s = __builtin_amdgcn_rsqf(sc[ai][m] * (1.0f / D) + EPS);
                bf16* hr = H + (size_t)row * FF + col0;
#pragma unroll
                for (int bj = 0; bj < 2; ++bj) {
                    f32x4 v0 = acc[ai][bj][m][0] * s, v1 = acc[ai][bj][m][1] * s;
#pragma unroll
                    for (int e = 0; e < 4; ++e) { const float a0 = fmaxf(v0[e], 0.f), a1 = fmaxf(v1[e], 0.f); v0[e] = a0 * a0; v1[e] = a1 * a1; }
                    u32x4 w; w.x = pg8::cvt_pk_bf16(v0[0], v0[1]); w.y = pg8::cvt_pk_bf16(v0[2], v0[3]); w.z = pg8::cvt_pk_bf16(v1[0], v1[1]); w.w = pg8::cvt_pk_bf16(v1[2], v1[3]);
                    __builtin_nontemporal_store(w, (u32x4*)(hr + bj * 128));
                }
            }
    }
};
struct SampleDownOrder {
    int G, c;
    __device__ void init(int G_, int c_) { G = G_; c = c_; }
    __device__ bool next(int i, pg8::Unit& u) const {
        const int L = i * G + c; if (L >= 256) return false;
        const int su = L >> 4, ks = L & 15; u.pm = NP / 256 + (su >> 2); u.pn = su & 3; u.k0 = ks * 256; u.nt = 4; return true;
    }
    __device__ __forceinline__ void a_ready(const pg8::Unit&) const {}
    __device__ __forceinline__ void done(const pg8::Unit&) const {}
};
struct EpiDown {
    static constexpr bool PERM = true, AFTER_DRAIN = false;
    const bf16* xsrc; bf16* x2; float* part;
    __device__ __forceinline__ void operator()(const f32x4 (&acc)[2][2][4][2], const pg8::Unit& u, int wr, int wc, int fr, int fq) const {
        const int row0 = u.pm * 256 + wr * 64 + fr, col0 = u.pn * 256 + wc * 32 + 8 * fq;
        if (u.nt != FF / 64) {
#pragma unroll
            for (int ai = 0; ai < 2; ++ai)
#pragma unroll
                for (int m = 0; m < 4; ++m) {
                    float* pr = part + ((size_t)(u.k0 >> 8) * NS + (size_t)(row0 + ai * 128 + m * 16 - NP)) * D + col0;
#pragma unroll
                    for (int bj = 0; bj < 2; ++bj) { *(f32x4*)(pr + bj * 128) = acc[ai][bj][m][0]; *(f32x4*)(pr + bj * 128 + 4) = acc[ai][bj][m][1]; }
                }
            return;
        }
#pragma unroll
        for (int ai = 0; ai < 2; ++ai) {
            u32x4 pre[4][2];
#pragma unroll
            for (int m = 0; m < 4; ++m)
#pragma unroll
                for (int bj = 0; bj < 2; ++bj) pre[m][bj] = *(const u32x4*)(xsrc + (size_t)(row0 + ai * 128 + m * 16) * D + col0 + bj * 128);
#pragma unroll
            for (int m = 0; m < 4; ++m) {
                bf16* xr = x2 + (size_t)(row0 + ai * 128 + m * 16) * D + col0;
#pragma unroll
                for (int bj = 0; bj < 2; ++bj) { const u32x4 r = pre[m][bj];
                    const f32x4 o0 = acc[ai][bj][m][0] + (f32x4){bflo(r.x), bfhi(r.x), bflo(r.y), bfhi(r.y)}, o1 = acc[ai][bj][m][1] + (f32x4){bflo(r.z), bfhi(r.z), bflo(r.w), bfhi(r.w)};
                    u32x4 w; w.x = pg8::cvt_pk_bf16(o0[0], o0[1]); w.y = pg8::cvt_pk_bf16(o0[2], o0[3]); w.z = pg8::cvt_pk_bf16(o1[0], o1[1]); w.w = pg8::cvt_pk_bf16(o1[2], o1[3]);
                    *(u32x4*)(xr + bj * 128) = w; }
            }
            asm volatile("" ::: "memory");
        }
    }
};

#define LDS_WAIT() asm volatile("s_waitcnt lgkmcnt(0)" ::: "memory")
__device__ __forceinline__ void p0_transpose_item(const float* W, int N, const float* gk, bf16* WT, int ldk, int koff, LAS unsigned char* scr, int item, int lane) {
    const int nblk = N / 128, kb = item / nblk, nb = item % nblk, k0 = 32 * kb, n0 = 128 * nb;
    f32x4 t[16];
#pragma unroll
    for (int i = 0; i < 16; ++i) t[i] = *(const f32x4*)(W + (size_t)(k0 + 2 * i + (lane >> 5)) * N + n0 + 4 * (lane & 31));
    if (gk) {
#pragma unroll
        for (int i = 0; i < 16; ++i) t[i] = t[i] * gk[k0 + 2 * i + (lane >> 5)];
    }
#pragma unroll
    for (int i = 0; i < 16; ++i) { u32x2 w; w.x = pk2(t[i].x, t[i].y); w.y = pk2(t[i].z, t[i].w); *(LAS u32x2*)(scr + (2 * i + (lane >> 5)) * 280 + 8 * (lane & 31)) = w; }
    LDS_WAIT(); asm volatile("" ::: "memory");
    const int kc = lane & 3;
#pragma unroll
    for (int j = 0; j < 8; ++j) { const int n = (lane >> 2) + 16 * j; const LAS unsigned short* sp = (const LAS unsigned short*)(scr + (8 * kc) * 280 + 2 * n);
        u32x4 o; o.x = (unsigned)sp[0] | ((unsigned)sp[140] << 16); o.y = (unsigned)sp[280] | ((unsigned)sp[420] << 16); o.z = (unsigned)sp[560] | ((unsigned)sp[700] << 16); o.w = (unsigned)sp[840] | ((unsigned)sp[980] << 16);
        *(u32x4*)(WT + (size_t)(n0 + n) * ldk + koff + k0 + 8 * kc) = o; }
    LDS_WAIT(); asm volatile("" ::: "memory");
}

#define XB_TMO      128
#define XB_XCNT(j)  (256  + 64 * (j))
#define XB_XSUB(j)  (1280 + 64 * (j))
#define XB_XGEN(j)  (2304 + 64 * (j))
#define XB_TOP      3328
#define XB_TOPGEN   3392
#define XCD_BAR_WORDS 3456
#define XB_SPIN_CAP (1u << 18)

__device__ __forceinline__ unsigned xb_ld(unsigned* p)              { return __hip_atomic_load(p, __ATOMIC_RELAXED, __HIP_MEMORY_SCOPE_AGENT); }
__device__ __forceinline__ unsigned xb_add(unsigned* p, unsigned v) { return __hip_atomic_fetch_add(p, v, __ATOMIC_RELAXED, __HIP_MEMORY_SCOPE_AGENT); }
__device__ __forceinline__ unsigned xb_xcc_id() { return (unsigned)__builtin_amdgcn_s_getreg((3 << 11) | 20) & 0xFu; }
#define XB_SPIN(cond, bar) do { unsigned _sp = 0; while (cond) { __builtin_amdgcn_s_sleep(1); \
    if ((++_sp & 255u) == 0u) { if (xb_ld(&(bar)[XB_TMO])) break; if (_sp > XB_SPIN_CAP) { atomicAdd(&(bar)[XB_TMO], 1u); break; } } } } while (0)

struct XcdBarrier {
    unsigned* bar; unsigned x;
    volatile LAS unsigned* st;
};

__device__ __forceinline__ XcdBarrier xcd_barrier_post(unsigned* bar, volatile LAS unsigned* st) {
    XcdBarrier b; b.bar = bar; b.x = xb_xcc_id(); b.st = st;
    if (threadIdx.x == 0) (void)xb_add(&bar[XB_XCNT(b.x)], 1u);
    return b;
}
__device__ __forceinline__ void xcd_barrier_complete(unsigned* bar, unsigned x, unsigned& nloc, unsigned& nx) {
    const unsigned G = gridDim.x * gridDim.y * gridDim.z;
    unsigned sum, cnt, mine, sp = 0u;
    for (;;) {
        sum = 0u; cnt = 0u; mine = 0u;
#pragma unroll
        for (unsigned j = 0; j < 16; ++j) { const unsigned c = xb_ld(&bar[XB_XCNT(j)]); sum += c; cnt += (c > 0u) ? 1u : 0u; mine = (j == x) ? c : mine; }
        if (sum == G) break;
        __builtin_amdgcn_s_sleep(1);
        if ((++sp & 255u) == 0u) { if (xb_ld(&bar[XB_TMO])) break; if (sp > XB_SPIN_CAP) { atomicAdd(&bar[XB_TMO], 1u); break; } }
    }
    nloc = mine > 0u ? mine : 1u; nx = cnt > 0u ? cnt : 1u;
}

__device__ __forceinline__ void xcd_barrier(const XcdBarrier& b) {
    asm volatile("s_waitcnt vmcnt(0)" ::: "memory");
    __syncthreads();
    if (threadIdx.x == 0) {
        unsigned* bar = b.bar;
        __builtin_amdgcn_s_waitcnt(0);
        unsigned nloc = b.st[0], nx = b.st[1];
        if (nloc == 0u) { xcd_barrier_complete(bar, b.x, nloc, nx); b.st[0] = nloc; b.st[1] = nx; }
        const unsigned old = xb_add(&bar[XB_XSUB(b.x)], 1u);
        const unsigned gen = old / nloc;
        if (old + 1u == (gen + 1u) * nloc) {
            __builtin_amdgcn_fence(__ATOMIC_RELEASE, "agent");
            asm volatile("s_waitcnt vmcnt(0)" ::: "memory");
            const unsigned og = xb_add(&bar[XB_TOP], 1u);
            const unsigned tg = og / nx;
            if (og + 1u == (tg + 1u) * nx) xb_add(&bar[XB_TOPGEN], 1u);
            else XB_SPIN(xb_ld(&bar[XB_TOPGEN]) == tg, bar);
            __builtin_amdgcn_fence(__ATOMIC_ACQUIRE, "agent");
            xb_add(&bar[XB_XGEN(b.x)], 1u);
            asm volatile("s_waitcnt vmcnt(0)" ::: "memory");
        } else {
            XB_SPIN(xb_ld(&bar[XB_XGEN(b.x)]) == gen, bar);
            __builtin_amdgcn_fence(__ATOMIC_ACQUIRE, "agent");
            asm volatile("s_waitcnt vmcnt(0)" ::: "memory");
        }
    }
    __syncthreads();
}

#define TID_OPAQUE() ({ int t_ = (int)threadIdx.x; asm volatile("" : "+v"(t_)); t_; })
__device__ __forceinline__ void xconv_rows(const float* xp, const float* xs, bf16* XB, float* rs0, int rb, int re, int gwl, int ngw) {
    const int lane = TID_OPAQUE() & 63;
    for (int m = rb + 2 * gwl; m < re; m += 2 * ngw) {
        const f32x4* xr0 = (const f32x4*)(m < NP ? xp + (size_t)m * D : xs + (size_t)(m - NP) * D) + lane; const f32x4* xr1 = xr0 + D / 4;
        f32x4 v[8]; float s0 = 0.f, s1 = 0.f;
#pragma unroll
        for (int j = 0; j < 4; ++j) { v[j] = __builtin_nontemporal_load(xr0 + 64 * j); v[4 + j] = __builtin_nontemporal_load(xr1 + 64 * j); }
#pragma unroll
        for (int j = 0; j < 4; ++j) { s0 += (v[j].x * v[j].x + v[j].y * v[j].y) + (v[j].z * v[j].z + v[j].w * v[j].w); s1 += (v[4 + j].x * v[4 + j].x + v[4 + j].y * v[4 + j].y) + (v[4 + j].z * v[4 + j].z + v[4 + j].w * v[4 + j].w); }
        s0 = wave_sum(s0); s1 = wave_sum(s1);
        if (lane == 0) { rs0[m] = 1.0f / sqrtf(s0 * (1.0f / D) + EPS); rs0[m + 1] = 1.0f / sqrtf(s1 * (1.0f / D) + EPS); }
        u32x2* o8 = (u32x2*)(XB + (size_t)m * D) + lane;
#pragma unroll
        for (int j = 0; j < 4; ++j) { u32x2 w; w.x = pk2(v[j].x, v[j].y); w.y = pk2(v[j].z, v[j].w); o8[64 * j] = w; u32x2 w1; w1.x = pk2(v[4 + j].x, v[4 + j].y); w1.y = pk2(v[4 + j].z, v[4 + j].w); o8[D / 4 + 64 * j] = w1; }
    }
}
__device__ __forceinline__ void pool_quads(const bf16* Z, const bf16* HB, bf16* MIX, int qb, int qe, int gwl, int ngw) {
    const int lane = TID_OPAQUE() & 63;
    const int nq = qe - qb, q0 = qb + (int)(((long)gwl * nq) / ngw), q1 = qb + (int)(((long)(gwl + 1) * nq) / ngw);
    const int c = lane * 8, w = 2 << (lane >> 4);
    for (int q = q0; q < q1; ++q) {
        const int m = 4 * q; const bool samp = m >= NP; const int t0 = samp ? ((m - NP) & (DSEQ - 1)) : (m & (SEQ - 1)); const int sidx = samp ? ((m - NP) >> 6) : 0;
        u32x4 L[19];
#pragma unroll
        for (int j = 0; j < 19; ++j) {
            const int tj = t0 - 15 + j;
            const bf16* p = (tj >= 0) ? Z + (size_t)(m - 15 + j) * INW + c : (samp ? HB + (size_t)(sidx * HIST + HIST + tj) * PW + c : Z + (size_t)m * INW + c);
            L[j] = *(const u32x4*)p;
        }
        float sum[4][8];
#pragma unroll
        for (int r = 0; r < 4; ++r)
#pragma unroll
            for (int e = 0; e < 8; ++e) sum[r][e] = 0.f;
#pragma unroll
        for (int j = 0; j < 19; ++j) {
            const bool valid = (t0 - 15 + j >= 0) || samp;
            const u32x4 r4 = L[j];
            float f[8] = {bflo(r4.x), bfhi(r4.x), bflo(r4.y), bfhi(r4.y), bflo(r4.z), bfhi(r4.z), bflo(r4.w), bfhi(r4.w)};
#pragma unroll
            for (int e = 0; e < 8; ++e) f[e] = valid ? f[e] : 0.f;
#pragma unroll
            for (int r = 0; r < 4; ++r) { const int k = 15 + r - j;
                if (k >= 0 && k <= 15) {
#pragma unroll
                    for (int e = 0; e < 8; ++e) sum[r][e] += (k < w) ? f[e] : 0.f;
                } }
        }
#pragma unroll
        for (int r = 0; r < 4; ++r) {
            const int cnt = samp ? w : ((t0 + r + 1 < w) ? t0 + r + 1 : w); const float inv = 1.0f / (float)cnt;
            const u32x4 a4 = L[15 + r];
            u32x4 o; o.x = pk2(sum[r][0] * inv - bflo(a4.x), sum[r][1] * inv - bfhi(a4.x)); o.y = pk2(sum[r][2] * inv - bflo(a4.y), sum[r][3] * inv - bfhi(a4.y));
            o.z = pk2(sum[r][4] * inv - bflo(a4.z), sum[r][5] * inv - bfhi(a4.z)); o.w = pk2(sum[r][6] * inv - bflo(a4.w), sum[r][7] * inv - bfhi(a4.w));
            *(u32x4*)(MIX + (size_t)(m + r) * D + c) = o;
        }
    }
}
__device__ __forceinline__ void gmlp_units(const bf16* Z, const bf16* Wm, const float* gb, bf16* MIX, LAS unsigned char* lds, int ub, int ue, int cb, int nb, int wave) {
    const int tid = TID_OPAQUE(), lane = tid & 63;
    for (int unit = ub + cb; unit < ue; unit += nb) {
        const int g = unit & 3, ch = unit >> 2; int m0, L;
        if (ch < 256) { m0 = ch * 128; L = 128; } else { m0 = NP + (ch - 256) * 64; L = 64; }
        const bf16* vsrc = Z + (size_t)m0 * INW + 1024 + g * 128;
        const int lp = (L == 128) ? 6 : 5;
        for (int item = tid; item < (16 << lp); item += 512) {
            const int pr = item & ((1 << lp) - 1), chunk = item >> lp;
            const u32x4 r0 = *(const u32x4*)(vsrc + (size_t)(2 * pr) * INW + chunk * 8), r1 = *(const u32x4*)(vsrc + (size_t)(2 * pr + 1) * INW + chunk * 8);
            LAS unsigned* vt = (LAS unsigned*)(lds + (chunk * 8) * 272 + pr * 4);
#pragma unroll
            for (int e2 = 0; e2 < 4; ++e2) { vt[(2 * e2) * 68] = (r0[e2] & 0xffffu) | (r1[e2] << 16); vt[(2 * e2 + 1) * 68] = (r0[e2] >> 16) | (r1[e2] & 0xffff0000u); }
        }
        __syncthreads();
        if (wave < (L >> 4)) {
            const int nk = (wave < 4) ? 2 : 4, iloc = wave * 16 + (lane & 15), kq = lane >> 4;
            const bf16* wrow = Wm + (size_t)(g * 128 + iloc) * 128 + kq * 8;
            f32x4 acc[8];
#pragma unroll
            for (int mt = 0; mt < 8; ++mt) acc[mt] = (f32x4){0.f, 0.f, 0.f, 0.f};
            for (int ks = 0; ks < nk; ++ks) {
                const bf16x8 bfrag = *(const bf16x8*)(wrow + ks * 32);
#pragma unroll
                for (int mt = 0; mt < 8; ++mt) {
                    const bf16x8 afrag = *(const LAS bf16x8*)(lds + (mt * 16 + (lane & 15)) * 272 + (ks * 32 + kq * 8) * 2);
                    acc[mt] = __builtin_amdgcn_mfma_f32_16x16x32_bf16(afrag, bfrag, acc[mt], 0, 0, 0);
                }
            }
            const int m = m0 + iloc; const float bias = gb[g * 128 + iloc];
            const bf16* urow = Z + (size_t)m * INW + 512 + g * 128 + 4 * kq; bf16* orow = MIX + (size_t)m * D + 512 + g * 128 + 4 * kq;
#pragma unroll
            for (int mt = 0; mt < 8; ++mt) {
                const u32x2 uu = *(const u32x2*)(urow + mt * 16);
                u32x2 o; o.x = pk2(bflo(uu.x) * (acc[mt][0] + bias), bfhi(uu.x) * (acc[mt][1] + bias)); o.y = pk2(bflo(uu.y) * (acc[mt][2] + bias), bfhi(uu.y) * (acc[mt][3] + bias));
                *(u32x2*)(orow + mt * 16) = o;
            }
        }
        __syncthreads();
    }
}
__device__ __forceinline__ void final_rows(float* out, const bf16* X2B, const bf16* XB1, const float* PART, const float* gf, int rb, int re, int gwl, int ngw) {
    const int lane = TID_OPAQUE() & 63;
    f32x4 gg[4];
#pragma unroll
    for (int j = 0; j < 4; ++j) gg[j] = ((const f32x4*)gf)[lane + 64 * j];
    for (int m = rb + 2 * gwl; m < re; m += 2 * ngw) {
        f32x4* xr = (f32x4*)(out + (size_t)m * D) + lane;
        f32x4 v[8]; float s0 = 0.f, s1 = 0.f;
        const u32x2* xb = (const u32x2*)((m < NP ? X2B : XB1) + (size_t)m * D) + lane;
#pragma unroll
        for (int j = 0; j < 4; ++j) { const u32x2 r0 = __builtin_nontemporal_load(xb + 64 * j), r1 = __builtin_nontemporal_load(xb + D / 4 + 64 * j);
            v[j] = (f32x4){bflo(r0.x), bfhi(r0.x), bflo(r0.y), bfhi(r0.y)}; v[4 + j] = (f32x4){bflo(r1.x), bfhi(r1.x), bflo(r1.y), bfhi(r1.y)}; }
        if (m >= NP) {
            const f32x4* pp = (const f32x4*)(PART + (size_t)(m - NP) * D) + lane;
#pragma unroll 2
            for (int ks = 0; ks < 16; ++ks) {
#pragma unroll
                for (int j = 0; j < 4; ++j) { v[j] += pp[(size_t)ks * (NS * D / 4) + 64 * j]; v[4 + j] += pp[(size_t)ks * (NS * D / 4) + D / 4 + 64 * j]; }
            }
        }
#pragma unroll
        for (int j = 0; j < 4; ++j) { s0 += (v[j].x * v[j].x + v[j].y * v[j].y) + (v[j].z * v[j].z + v[j].w * v[j].w); s1 += (v[4 + j].x * v[4 + j].x + v[4 + j].y * v[4 + j].y) + (v[4 + j].z * v[4 + j].z + v[4 + j].w * v[4 + j].w); }
        s0 = wave_sum(s0); s1 = wave_sum(s1);
        const float r0 = 1.0f / sqrtf(s0 * (1.0f / D) + EPS), r1 = 1.0f / sqrtf(s1 * (1.0f / D) + EPS);
#pragma unroll
        for (int j = 0; j < 4; ++j) { __builtin_nontemporal_store(v[j] * r0 * gg[j], xr + 64 * j); __builtin_nontemporal_store(v[4 + j] * r1 * gg[j], xr + D / 4 + 64 * j); }
    }
}

struct Args { const float* in[14]; float* out; unsigned char* ws; };

__global__ void __launch_bounds__(512, 2) fwd_megakernel(Args a) {
    extern __shared__ __attribute__((aligned(16))) unsigned char lds_raw[];
    LAS unsigned char* lds = (LAS unsigned char*)lds_raw;
    const int wave = __builtin_amdgcn_readfirstlane((int)threadIdx.x >> 6);
    const int G = gridDim.x, bx = blockIdx.x, gw = bx * 8 + wave, NGW = G * 8;
    const float *xp = a.in[0], *xs = a.in[1], *spool = a.in[2], *g1 = a.in[3], *w_in = a.in[4], *pool_w = a.in[5], *pool_scale = a.in[6], *gws = a.in[7], *gb = a.in[8],
                *w_out = a.in[9], *g2 = a.in[10], *w_up = a.in[11], *w_down = a.in[12], *gf = a.in[13];
    float* out = a.out; unsigned char* ws = a.ws;
    bf16 *XB = (bf16*)(ws + WS_XB), *Z = (bf16*)(ws + WS_Z), *MIX = (bf16*)(ws + WS_MIX), *XB1 = (bf16*)(ws + WS_XB1), *H = (bf16*)(ws + WS_H);
    bf16 *WinT = (bf16*)(ws + WS_WIN), *WoT = (bf16*)(ws + WS_WO), *WupT = (bf16*)(ws + WS_WUP), *WdT = (bf16*)(ws + WS_WDN), *Wm = (bf16*)(ws + WS_WM);
    float *rs0 = (float*)(ws + WS_RS0), *ssq1 = (float*)(ws + WS_SSQ1); bf16* HB = (bf16*)(ws + WS_HB); float* PART = (float*)(ws + WS_PART); bf16* X2B = (bf16*)(ws + WS_X2B);
    if (threadIdx.x < 2) ((volatile LAS unsigned*)(lds + BARST_OFF))[threadIdx.x] = 0u;
    __syncthreads();
    (void)xcd_barrier_post((unsigned*)(ws + WS_CTL), (volatile LAS unsigned*)(lds + BARST_OFF));
#define GRID_BAR() do { XcdBarrier b_; b_.bar = (unsigned*)(a.ws + WS_CTL); b_.x = xb_xcc_id(); b_.st = (volatile LAS unsigned*)(lds + BARST_OFF); xcd_barrier(b_); } while (0)
    const int S1 = G >= 48 ? 24 : G / 2, S3 = G >= 32 ? 16 : G / 2, S4 = G >= 128 ? 64 : G / 2;
    LAS unsigned char* scr = lds + wave * 16384;
    constexpr int I_IN = (D / 32) * (INW / 128), I_OUT = (512 / 32) * (D / 128), I_UP = (D / 32) * (FF / 128), I_DN = (FF / 32) * (D / 128), I_FOLD = 4 * 16 * 16;

    {
    const int tid = TID_OPAQUE(), lane = tid & 63;
    for (int it = gw; it < I_IN; it += NGW) p0_transpose_item(w_in, INW, g1, WinT, D, 0, scr, it, lane);
    for (int i = bx * 512 + tid; i < 4 * 128 * 128; i += G * 512) { const int ii = (i >> 7) & 127, jj = i & 127; Wm[i] = (bf16)(((jj >> 6) <= (ii >> 6)) ? f2bf(gws[i]) : 0u); }
    for (int i = bx * 512 + tid; i < M; i += G * 512) ssq1[i] = 0.f;
    for (int i = bx * 512 + tid; i < 16 * HIST * PW / 2; i += G * 512) ((unsigned*)HB)[i] = pk2(spool[2 * i], spool[2 * i + 1]);
    }
    xconv_rows(xp, xs, XB, rs0, NP, M, gw, NGW);
    GRID_BAR();

    if (bx < S1) {
        pg8::Gemm g{XB, WinT, M, INW, D}; pg8::StaticOrder S; S.init(NS, INW, D, S1, bx); S.pm_base = NP / 256;
        EpiIn E{Z, rs0, out};
        pg8::gemm_phase<EpiIn, pg8::StaticOrder, true, true>(lds, g, S, E);
        asm volatile("s_waitcnt vmcnt(0)" ::: "memory"); __syncthreads();
        if (threadIdx.x == 0) {
            unsigned* cnt = (unsigned*)(a.ws + WS_CTL) + 3600;
            __builtin_amdgcn_fence(__ATOMIC_RELEASE, "agent"); asm volatile("s_waitcnt vmcnt(0)" ::: "memory");
            (void)xb_add(cnt, 1u);
            unsigned sp = 0; while (xb_ld(cnt) < (unsigned)S1) { __builtin_amdgcn_s_sleep(2); if (++sp > (1u << 22)) break; }
            __builtin_amdgcn_fence(__ATOMIC_ACQUIRE, "agent"); asm volatile("s_waitcnt vmcnt(0)" ::: "memory");
        }
        __syncthreads();
        pool_quads(Z, HB, MIX, NP / 4, M / 4, gw, S1 * 8);
        gmlp_units(Z, Wm, gb, MIX, lds, 1024, 1088, bx, S1, wave);
    } else {
        const int gwl = (bx - S1) * 8 + wave, ngw = (G - S1) * 8; const int lane = TID_OPAQUE() & 63;
        constexpr int NITEMS = I_OUT + I_UP + I_DN + I_FOLD;
        for (int rep = 0; rep < ((PROBE == 22 || PROBE == 23) ? 2 : 1); ++rep)
        for (int it = gwl; it < NITEMS; it += ngw) {
            int r = it;
            if (PROBE == 22 && rep == 1 && r >= I_OUT + I_UP + I_DN) continue;
            if (PROBE == 23 && rep == 1 && r < I_OUT + I_UP + I_DN) continue;
            if (r < I_OUT) { p0_transpose_item(w_out + (size_t)512 * D, D, nullptr, WoT, D, 512, scr, r, lane); continue; } r -= I_OUT;
            if (r < I_UP) { p0_transpose_item(w_up, FF, g2, WupT, D, 0, scr, r, lane); continue; } r -= I_UP;
            if (r < I_DN) { p0_transpose_item(w_down, D, nullptr, WdT, FF, 0, scr, r, lane); continue; } r -= I_DN;
            const int g = r >> 8, c0 = ((r >> 4) & 15) * 8, n = (r & 15) * 64 + lane;
            float acc[8];
#pragma unroll
            for (int c = 0; c < 8; ++c) acc[c] = 0.f;
            const float* pw = pool_w + (size_t)(g * 128 + c0) * 128;
            for (int e0 = 0; e0 < 128; e0 += 16) {
                float wv[16];
#pragma unroll
                for (int e = 0; e < 16; ++e) wv[e] = w_out[(size_t)(g * 128 + e0 + e) * D + n];
#pragma unroll
                for (int e = 0; e < 16; ++e) { const float ws_ = wv[e] * pool_scale[g * 128 + e0 + e];
#pragma unroll
                    for (int c = 0; c < 8; ++c) acc[c] += pw[c * 128 + e0 + e] * ws_; }
            }
            u32x4 o; o.x = pk2(acc[0], acc[1]); o.y = pk2(acc[2], acc[3]); o.z = pk2(acc[4], acc[5]); o.w = pk2(acc[6], acc[7]);
            *(u32x4*)(WoT + (size_t)n * D + g * 128 + c0) = o;
        }
        xconv_rows(xp, xs, XB, rs0, 0, NP, gwl, ngw);
        if (PROBE == 21) xconv_rows(xp, xs, XB, rs0, 0, NP, gwl, ngw);
    }
    GRID_BAR();

    {
        pg8::Gemm g{XB, WinT, M, INW, D}; pg8::StaticOrder S; S.init(NP, INW, D, G, bx);
        EpiIn E{Z, rs0, out};
        pg8::gemm_phase<EpiIn, pg8::StaticOrder, true, true>(lds, g, S, E);
    }
    GRID_BAR();

    if (bx < S3) {
        pg8::Gemm g{MIX, WoT, M, D, D}; pg8::StaticOrder S; S.init(NS, D, D, S3, bx); S.pm_base = NP / 256;
        EpiOut E{XB, XB1, ssq1};
        pg8::gemm_phase<EpiOut, pg8::StaticOrder, true, true>(lds, g, S, E);
    } else {
        pool_quads(Z, HB, MIX, 0, NP / 4, (bx - S3) * 8 + wave, (G - S3) * 8);
        gmlp_units(Z, Wm, gb, MIX, lds, 0, 1024, bx - S3, G - S3, wave);
    }
    GRID_BAR();

    {
        pg8::Gemm g{MIX, WoT, M, D, D}; pg8::StaticOrder S; S.init(NP, D, D, G, bx);
        EpiOut E{XB, XB1, ssq1};
        pg8::gemm_phase<EpiOut, pg8::StaticOrder, true, true>(lds, g, S, E);
    }
    GRID_BAR();

    {
        pg8::Gemm g{XB1, WupT, M, FF, D}; pg8::StaticOrder S; S.init(NP, FF, D, G, bx);
        EpiUp E{H, ssq1};
        pg8::gemm_phase<EpiUp, pg8::StaticOrder, true, true>(lds, g, S, E);
    }
    GRID_BAR();

    {
        pg8::Gemm g{H, WdT, M, D, FF}; pg8::StaticOrder S; S.init(NP, D, FF, G, bx);
        EpiDown E{XB1, X2B, PART};
        pg8::gemm_phase<EpiDown, pg8::StaticOrder, true, true>(lds, g, S, E);
    }
    GRID_BAR();

    if (bx < S4) {
        pg8::Gemm g{XB1, WupT, M, FF, D}; pg8::StaticOrder S; S.init(NS, FF, D, S4, bx); S.pm_base = NP / 256;
        EpiUp E{H, ssq1};
        pg8::gemm_phase<EpiUp, pg8::StaticOrder, true, true>(lds, g, S, E);
    } else {
        final_rows(out, X2B, XB1, PART, gf, 0, NP, (bx - S4) * 8 + wave, (G - S4) * 8);
    }
    GRID_BAR();

    {
        pg8::Gemm g{H, WdT, M, D, FF}; SampleDownOrder S; S.init(G, bx);
        EpiDown E{XB1, X2B, PART};
        pg8::gemm_phase<EpiDown, SampleDownOrder, true, true>(lds, g, S, E);
    }
    GRID_BAR();

    if (PROBE == 7) { for (int k = 0; k < 10; ++k) GRID_BAR(); }
    final_rows(out, X2B, XB1, PART, gf, NP, M, gw, NGW);
}

extern "C" void kernel_launch(void* const* d_in, const int* in_sizes, int n_in, void* d_out, int out_size, void* d_ws, size_t ws_size, hipStream_t stream) {
    static int grid = 0;
    if (grid == 0) {
        if (n_in != 14 || in_sizes[0] != NP * D || in_sizes[1] != NS * D || (size_t)out_size != O_END || ws_size < WS_END) {
            fprintf(stderr, "kernel_launch: unexpected shapes (n_in %d in0 %d out %d ws %zu)\n", n_in, n_in > 0 ? in_sizes[0] : -1, out_size, ws_size); grid = -1; return; }
        int dev = 0, cus = 0, per_cu = 0;
        if (hipGetDevice(&dev) != hipSuccess || hipDeviceGetAttribute(&cus, hipDeviceAttributeMultiprocessorCount, dev) != hipSuccess) { grid = -1; return; }
        if (hipFuncSetAttribute((const void*)fwd_megakernel, hipFuncAttributeMaxDynamicSharedMemorySize, LDS_BYTES) != hipSuccess) { fprintf(stderr, "kernel_launch: hipFuncSetAttribute failed\n"); grid = -1; return; }
        if (hipOccupancyMaxActiveBlocksPerMultiprocessor(&per_cu, (const void*)fwd_megakernel, 512, LDS_BYTES) != hipSuccess || per_cu < 1) { fprintf(stderr, "kernel_launch: occupancy query gave %d\n", per_cu); (void)hipGetLastError(); per_cu = 1; }
        grid = cus * per_cu;
    }
    if (grid < 0) return;
    if (hipMemsetAsync((char*)d_ws + WS_CTL, 0, CTL_ZERO_BYTES, stream) != hipSuccess) { fprintf(stderr, "kernel_launch: memset failed\n"); return; }
    Args a{};
    for (int i = 0; i < 14; ++i) a.in[i] = (const float*)d_in[i];
    a.out = (float*)d_out; a.ws = (unsigned char*)d_ws;
    void* args[] = {&a};
    const hipError_t e = hipLaunchCooperativeKernel((const void*)fwd_megakernel, dim3(grid), dim3(512), args, LDS_BYTES, stream);
    if (e != hipSuccess) fprintf(stderr, "kernel_launch: cooperative launch failed: %s (grid %d)\n", hipGetErrorString(e), grid);
}
```
